# Optimizing an MI355X kernel written in HIP

```python
import math
import jax
import jax.numpy as jnp
from jax import lax
import numpy as np

D_MODEL = 1024
BATCH = 4
SEQ = 4096
DEPTH = 2

N_MEM = 256
BRANCH_W = 256
N_BRANCH = 4
Q_BLOCK = 128
ROPE_THETA = 500000.0
ROPE_FRAC = 4
LN_EPS = 1e-5
ALPHA = (2 * DEPTH) ** 0.25
BETA = (8 * DEPTH) ** -0.25
RET_HEADS = 4
RET_DK = 32
RET_DV = 64
RET_CHUNK = 128
RET_THETA = 10000.0
DSA_HEADS = 4
DSA_DH = 64
IDX_HEADS = 8
IDX_DH = 32
DSA_TOPK = 256
NSA_HEADS = 4
NSA_DH = 64
CMP_LEN = 32
CMP_STRIDE = 16
SEL_LEN = 64
SEL_TOPN = 16
WINDOW = 512
SSM_HEADS = 4
SSM_HEADDIM = 64
SSM_GROUPS = 2
SSM_STATE = 128
SSM_CONV = 4
SSM_CHUNK = 128
SSM_INNER = SSM_HEADS * SSM_HEADDIM
SSM_CONV_DIM = SSM_INNER + 2 * SSM_GROUPS * SSM_STATE
D_FF = 2816
X_HEADS = 4
X_DH = D_MODEL // X_HEADS

IN_SPLITS = (
    RET_HEADS * RET_DK, RET_HEADS * RET_DK, RET_HEADS * RET_DV, RET_HEADS * RET_DV,
    DSA_HEADS * DSA_DH, DSA_DH, DSA_DH, IDX_HEADS * IDX_DH, IDX_DH, IDX_HEADS,
    NSA_HEADS * NSA_DH, NSA_DH, NSA_DH, NSA_DH, NSA_DH, NSA_DH, NSA_DH, NSA_HEADS * 3,
    SSM_INNER, SSM_CONV_DIM, SSM_HEADS,
    N_BRANCH * D_MODEL,
)
D_IN = sum(IN_SPLITS)

kernel_name = 'hybrid_gated_retention_dsa_nsa_ssd_trunk'


def layer_norm(x, g, b):
    xf = x.astype(jnp.float32)
    mu = jnp.mean(xf, -1, keepdims=True)
    var = jnp.mean(jnp.square(xf - mu), -1, keepdims=True)
    return ((xf - mu) * lax.rsqrt(var + LN_EPS)).astype(x.dtype) * g + b


def rope(x, pos, rot_dim, theta):
    half = rot_dim // 2
    inv = jnp.power(jnp.float32(theta), -2.0 * jnp.arange(half, dtype=jnp.float32) / rot_dim)
    ang = pos.astype(jnp.float32)[:, None] * inv[None, :]
    cos = jnp.cos(ang)[None, :, None, :].astype(x.dtype)
    sin = jnp.sin(ang)[None, :, None, :].astype(x.dtype)
    x1, x2, rest = x[..., :half], x[..., half:rot_dim], x[..., rot_dim:]
    return jnp.concatenate([x1 * cos - x2 * sin, x2 * cos + x1 * sin, rest], axis=-1)


def masked_softmax(s, mask):
    s = jnp.where(mask, s.astype(jnp.float32), -jnp.inf)
    m = jnp.max(s, -1, keepdims=True)
    m = jnp.where(jnp.isfinite(m), m, 0.0)
    e = jnp.exp(s - m)
    return e / jnp.maximum(jnp.sum(e, -1, keepdims=True), 1e-30)


def to_blocks(a, nb):
    return jnp.moveaxis(a.reshape(a.shape[0], nb, Q_BLOCK, *a.shape[2:]), 1, 0)


def from_blocks(a):
    a = jnp.moveaxis(a, 0, 1)
    return a.reshape(a.shape[0], a.shape[1] * a.shape[2], *a.shape[3:])


def swiglu(x, w_gu, w_down):
    g, u = jnp.split(x @ w_gu, 2, axis=-1)
    return (jax.nn.silu(g) * u) @ w_down


def retention(q, k, v, g, pos):
    B, S, H, dk = q.shape
    dv = v.shape[-1]
    C = RET_CHUNK
    n = S // C
    dt = v.dtype
    q = rope(q, pos, dk, RET_THETA)
    k = rope(k, pos, dk, RET_THETA) * (dk ** -0.5)
    log_gamma = jnp.log1p(-jnp.exp2(-5.0 - jnp.arange(H, dtype=jnp.float32)))
    c = jnp.arange(C, dtype=jnp.float32)
    rel = c[:, None] - c[None, :]
    intra_decay = jnp.where(rel >= 0, jnp.exp(jnp.maximum(rel, 0.0)[None] * log_gamma[:, None, None]), 0.0).astype(dt)
    zeta = jnp.exp((C - 1 - c)[None] * log_gamma[:, None]).astype(dt)
    xi = jnp.exp((c + 1)[None] * log_gamma[:, None]).astype(dt)
    chunk_decay = jnp.exp(C * log_gamma).astype(dt)
    qc = q.reshape(B, n, C, H, dk)
    kc = k.reshape(B, n, C, H, dk)
    vc = v.reshape(B, n, C, H, dv)
    scores = jnp.einsum('bnihd,bnjhd->bnhij', qc, kc) * intra_decay
    intra = jnp.einsum('bnhij,bnjhe->bnihe', scores, vc)
    contrib = jnp.einsum('bnjhd,bnjhe,hj->nbhde', kc, vc, zeta)

    def step(state, cin):
        return state * chunk_decay[None, :, None, None] + cin, state

    _, prev = lax.scan(step, jnp.zeros((B, H, dk, dv), dt), contrib)
    cross = jnp.einsum('bnihd,nbhde,hi->bnihe', qc, prev, xi)
    o = (intra + cross).reshape(B, S, H, dv).astype(jnp.float32)
    mu = jnp.mean(o, -1, keepdims=True)
    var = jnp.mean(jnp.square(o - mu), -1, keepdims=True)
    o = ((o - mu) * lax.rsqrt(var + LN_EPS)).astype(dt)
    return jax.nn.silu(g) * o.reshape(B, S, H * dv)


def dsa_attention(q, k, v, iq, ik, iw, pos):
    B, S, H, Dh = q.shape
    n_keep = min(DSA_TOPK, S // 4)
    nb = S // Q_BLOCK
    q = rope(q, pos, Dh // ROPE_FRAC, ROPE_THETA)
    k = rope(k[:, :, None], pos, Dh // ROPE_FRAC, ROPE_THETA)[:, :, 0]
    iq = rope(iq, pos, IDX_DH // ROPE_FRAC, ROPE_THETA)
    ik = rope(ik[:, :, None], pos, IDX_DH // ROPE_FRAC, ROPE_THETA)[:, :, 0]
    iw = iw * (IDX_HEADS ** -0.5) * (IDX_DH ** -0.5)
    kpos = jnp.arange(S)
    gather = jax.vmap(lambda t, i: t[i])

    def block(args):
        qb, iqb, iwb, bi = args
        qpos = bi * Q_BLOCK + jnp.arange(Q_BLOCK)
        rel = jax.nn.relu(jnp.einsum('bqhd,bkd->bqkh', iqb, ik))
        score = jnp.einsum('bqkh,bqh->bqk', rel, iwb).astype(jnp.float32)
        causal = kpos[None, :] <= qpos[:, None]
        score = jnp.where(causal[None], score, -jnp.inf)
        _, idx = lax.top_k(score, n_keep)
        ks = gather(k, idx)
        vs = gather(v, idx)
        s = jnp.einsum('bqhd,bqnd->bhqn', qb, ks) * (Dh ** -0.5)
        valid = (idx <= qpos[None, :, None])[:, None]
        p = masked_softmax(s, valid).astype(vs.dtype)
        return jnp.einsum('bhqn,bqnd->bqhd', p, vs)

    out = lax.map(block, (to_blocks(q, nb), to_blocks(iq, nb), to_blocks(iw, nb), jnp.arange(nb)))
    return from_blocks(out).reshape(B, S, H * Dh)


def nsa_attention(q, kc, vc, ks, vs, kw, vw, gates, cmp_w1, cmp_w2, cmp_pos, pos):
    B, S, H, Dh = q.shape
    rot = Dh // ROPE_FRAC
    scale = Dh ** -0.5
    q = rope(q, pos, rot, ROPE_THETA)
    r1 = lambda t: rope(t[:, :, None], pos, rot, ROPE_THETA)[:, :, 0]
    kc, ks, kw = r1(kc), r1(ks), r1(kw)
    n_cmp = (S - CMP_LEN) // CMP_STRIDE + 1
    starts = jnp.arange(n_cmp) * CMP_STRIDE
    tok = starts[:, None] + jnp.arange(CMP_LEN)[None]

    def compress(t, i):
        blk = t[:, tok] + cmp_pos[i]
        h = jax.nn.gelu(blk.reshape(B, n_cmp, CMP_LEN * Dh) @ cmp_w1[i])
        return h @ cmp_w2[i]

    k_cmp = compress(kc, 0)
    v_cmp = compress(vc, 1)
    cmp_visible = (starts + CMP_LEN - 1)[None, :] <= pos[:, None]
    p_cmp = masked_softmax(jnp.einsum('bshd,bcd->bhsc', q, k_cmp) * scale, cmp_visible[None, None])
    o_cmp = jnp.einsum('bhsc,bcd->bshd', p_cmp.astype(v_cmp.dtype), v_cmp)
    n_blk = S // SEL_LEN
    sel_start = jnp.arange(n_blk) * SEL_LEN
    overlap = jnp.maximum(jnp.minimum(starts[:, None] + CMP_LEN, sel_start[None] + SEL_LEN)
                          - jnp.maximum(starts[:, None], sel_start[None]), 0).astype(jnp.float32) / CMP_LEN
    imp = jnp.einsum('bhsc,cj->bsj', p_cmp, overlap)
    blk = jnp.arange(n_blk)[None]
    cur = (pos // SEL_LEN)[:, None]
    forced = (blk == 0) | (blk == cur) | (blk == cur - 1)
    admissible = sel_start[None] <= pos[:, None]
    imp = jnp.where(admissible[None], jnp.where(forced[None], jnp.inf, imp), -jnp.inf)
    n_top = min(SEL_TOPN, n_blk)
    _, sel_idx = lax.top_k(imp, n_top)
    ks_blk = ks.reshape(B, n_blk, SEL_LEN, Dh)
    vs_blk = vs.reshape(B, n_blk, SEL_LEN, Dh)
    kw_pad = jnp.pad(kw, ((0, 0), (WINDOW, 0), (0, 0)))
    vw_pad = jnp.pad(vw, ((0, 0), (WINDOW, 0), (0, 0)))
    nb = S // Q_BLOCK
    gather = jax.vmap(lambda t, i: t[i])
    sel_off = jnp.arange(SEL_LEN)
    win_off = jnp.arange(WINDOW + Q_BLOCK)

    def block(args):
        qb, idxb, bi = args
        qpos = bi * Q_BLOCK + jnp.arange(Q_BLOCK)
        ksel = gather(ks_blk, idxb).reshape(B, Q_BLOCK, n_top * SEL_LEN, Dh)
        vsel = gather(vs_blk, idxb).reshape(B, Q_BLOCK, n_top * SEL_LEN, Dh)
        kpos_sel = (idxb[..., None] * SEL_LEN + sel_off).reshape(B, Q_BLOCK, n_top * SEL_LEN)
        p = masked_softmax(jnp.einsum('bqhd,bqkd->bhqk', qb, ksel) * scale,
                           (kpos_sel <= qpos[None, :, None])[:, None])
        o_sel = jnp.einsum('bhqk,bqkd->bqhd', p.astype(vsel.dtype), vsel)
        kwin = lax.dynamic_slice_in_dim(kw_pad, bi * Q_BLOCK, WINDOW + Q_BLOCK, axis=1)
        vwin = lax.dynamic_slice_in_dim(vw_pad, bi * Q_BLOCK, WINDOW + Q_BLOCK, axis=1)
        kpos_w = bi * Q_BLOCK - WINDOW + win_off
        dlt = qpos[:, None] - kpos_w[None]
        wmask = (dlt >= 0) & (dlt < WINDOW) & (kpos_w[None] >= 0)
        p = masked_softmax(jnp.einsum('bqhd,bkd->bhqk', qb, kwin) * scale, wmask[None, None])
        o_win = jnp.einsum('bhqk,bkd->bqhd', p.astype(vwin.dtype), vwin)
        return o_sel, o_win

    o_sel, o_win = lax.map(block, (to_blocks(q, nb), to_blocks(sel_idx, nb), jnp.arange(nb)))
    o_sel, o_win = from_blocks(o_sel), from_blocks(o_win)
    g = jax.nn.sigmoid(gates.reshape(B, S, H, 3))
    o = g[..., 0:1] * o_cmp + g[..., 1:2] * o_sel + g[..., 2:3] * o_win
    return o.reshape(B, S, H * Dh)


def ssd_mixer(z, xbc, dt_raw, conv_w, conv_b, dt_bias, a_log, d_skip, norm_g):
    B, S, _ = xbc.shape
    H, P, G, N = SSM_HEADS, SSM_HEADDIM, SSM_GROUPS, SSM_STATE
    Q = SSM_CHUNK
    nc = S // Q
    xbc = lax.conv_general_dilated(xbc, conv_w[:, None, :], window_strides=(1,),
                                   padding=[(SSM_CONV - 1, 0)],
                                   dimension_numbers=('NWC', 'WIO', 'NWC'),
                                   feature_group_count=SSM_CONV_DIM)
    xbc = jax.nn.silu(xbc + conv_b)
    xs, bm, cm = jnp.split(xbc, [SSM_INNER, SSM_INNER + G * N], axis=-1)
    dtx = xs.dtype
    xs = xs.reshape(B, S, H, P)
    bm = jnp.repeat(bm.reshape(B, S, G, N), H // G, axis=2)
    cm = jnp.repeat(cm.reshape(B, S, G, N), H // G, axis=2)
    dt = jax.nn.softplus((dt_raw + dt_bias).astype(jnp.float32))
    a = -jnp.exp(a_log.astype(jnp.float32))
    adt = dt * a
    X = (xs * dt[..., None].astype(dtx)).reshape(B, nc, Q, H, P)
    Bc = bm.reshape(B, nc, Q, H, N)
    Cc = cm.reshape(B, nc, Q, H, N)
    A = jnp.moveaxis(adt.reshape(B, nc, Q, H), 3, 1)
    A_cs = jnp.cumsum(A, axis=-1)
    seg = A_cs[..., :, None] - A_cs[..., None, :]
    tril = jnp.tril(jnp.ones((Q, Q), dtype=bool))
    Lm = jnp.exp(jnp.where(tril, seg, -jnp.inf)).astype(dtx)
    y_diag = jnp.einsum('bclhn,bcshn,bhcls,bcshp->bclhp', Cc, Bc, Lm, X)
    decay_states = jnp.exp(A_cs[..., -1:] - A_cs).astype(dtx)
    states = jnp.einsum('bclhn,bhcl,bclhp->cbhpn', Bc, decay_states, X)
    chunk_decay = jnp.moveaxis(jnp.exp(A_cs[..., -1]).astype(dtx), 2, 0)

    def step(h, inp):
        st, dec = inp
        return h * dec[..., None, None] + st, h

    _, prev = lax.scan(step, jnp.zeros((B, H, P, N), dtx), (states, chunk_decay))
    y_off = jnp.einsum('bclhn,cbhpn,bhcl->bclhp', Cc, prev, jnp.exp(A_cs).astype(dtx))
    y = (y_diag + y_off).reshape(B, S, H, P) + xs * d_skip[:, None]
    y = y.reshape(B, S, SSM_INNER) * jax.nn.silu(z)
    yg = y.reshape(B, S, G, SSM_INNER // G).astype(jnp.float32)
    yg = yg * lax.rsqrt(jnp.mean(yg * yg, -1, keepdims=True) + LN_EPS)
    return yg.reshape(B, S, SSM_INNER).astype(z.dtype) * norm_g


def token_mixing(x, w_in, cmp_w1, cmp_w2, cmp_pos, conv_w, conv_b, dt_bias, a_log, d_skip,
                 ssm_norm_g, w_branch, w_out):
    B, S, D = x.shape
    pos = jnp.arange(S)
    parts = jnp.split(x @ w_in, np.cumsum(IN_SPLITS)[:-1].tolist(), axis=-1)
    (r_q, r_k, r_v, r_g, d_q, d_k, d_v, i_q, i_k, i_w,
     n_q, n_kc, n_vc, n_ks, n_vs, n_kw, n_vw, n_g, s_z, s_xbc, s_dt, br_g) = parts
    y_ret = retention(r_q.reshape(B, S, RET_HEADS, RET_DK), r_k.reshape(B, S, RET_HEADS, RET_DK),
                      r_v.reshape(B, S, RET_HEADS, RET_DV), r_g, pos)
    y_dsa = dsa_attention(d_q.reshape(B, S, DSA_HEADS, DSA_DH), d_k, d_v,
                          i_q.reshape(B, S, IDX_HEADS, IDX_DH), i_k, i_w, pos)
    y_nsa = nsa_attention(n_q.reshape(B, S, NSA_HEADS, NSA_DH), n_kc, n_vc, n_ks, n_vs, n_kw, n_vw,
                          n_g, cmp_w1, cmp_w2, cmp_pos, pos)
    y_ssd = ssd_mixer(s_z, s_xbc, s_dt, conv_w, conv_b, dt_bias, a_log, d_skip, ssm_norm_g)
    ys = jnp.stack([y_ret, y_dsa, y_nsa, y_ssd], axis=2)
    gates = jax.nn.sigmoid(br_g.reshape(B, S, N_BRANCH, D))
    merged = jnp.einsum('bsnd,bsnd->bsd', gates, jnp.einsum('bsnw,nwd->bsnd', ys, w_branch))
    return merged @ w_out


def memory_cross_attention(x, mem, wq, wkv, wo):
    B, S, D = x.shape
    M = mem.shape[1]
    q = (x @ wq).reshape(B, S, X_HEADS, X_DH)
    kv = (mem @ wkv).reshape(B, M, 2, X_HEADS, X_DH)
    k, v = kv[:, :, 0], kv[:, :, 1]
    s = jnp.einsum('bshd,bmhd->bhsm', q, k) * (X_DH ** -0.5)
    p = jax.nn.softmax(s.astype(jnp.float32), axis=-1).astype(v.dtype)
    return jnp.einsum('bhsm,bmhd->bshd', p, v).reshape(B, S, D) @ wo


def setup_inputs(seed: int = 0) -> dict:
    key = jax.random.key(seed)
    ks = jax.random.split(key, 23)
    L, D = DEPTH, D_MODEL
    nrm = lambda k, shape, scale: jax.random.normal(k, shape, jnp.float32) * scale
    dt0 = jnp.exp(jax.random.uniform(ks[12], (L, SSM_HEADS), jnp.float32, math.log(1e-3), math.log(1e-1)))
    return {
        'x': nrm(ks[0], (BATCH, SEQ, D), 1.0),
        'mem': nrm(ks[1], (BATCH, N_MEM, D), 1.0),
        'ln_g': 1.0 + nrm(ks[2], (L, 4, D), 0.02),
        'ln_b': nrm(ks[3], (L, 4, D), 0.02),
        'ffn1_w_gu': nrm(ks[4], (L, D, 2 * D_FF), D ** -0.5),
        'ffn1_w_down': nrm(ks[5], (L, D_FF, D), BETA * D_FF ** -0.5),
        'w_in': nrm(ks[6], (L, D, D_IN), D ** -0.5),
        'cmp_w1': nrm(ks[7], (L, 2, CMP_LEN * NSA_DH, NSA_DH), (CMP_LEN * NSA_DH) ** -0.5),
        'cmp_w2': nrm(ks[8], (L, 2, NSA_DH, NSA_DH), NSA_DH ** -0.5),
        'cmp_pos': nrm(ks[9], (L, 2, CMP_LEN, NSA_DH), 0.1),
        'conv_w': nrm(ks[10], (L, SSM_CONV, SSM_CONV_DIM), SSM_CONV ** -0.5),
        'conv_b': nrm(ks[11], (L, SSM_CONV_DIM), 0.01),
        'dt_bias': dt0 + jnp.log(-jnp.expm1(-dt0)),
        'a_log': jnp.log(jax.random.uniform(ks[13], (L, SSM_HEADS), jnp.float32, 1.0, 16.0)),
        'd_skip': 1.0 + nrm(ks[14], (L, SSM_HEADS), 0.1),
        'ssm_norm_g': 1.0 + nrm(ks[15], (L, SSM_INNER), 0.02),
        'w_branch': nrm(ks[16], (L, N_BRANCH, BRANCH_W, D), BRANCH_W ** -0.5),
        'w_out': nrm(ks[17], (L, D, D), BETA * D ** -0.5),
        'xattn_wq': nrm(ks[18], (L, D, D), D ** -0.5),
        'xattn_wkv': nrm(ks[19], (L, D, 2 * D), D ** -0.5),
        'xattn_wo': nrm(ks[20], (L, D, D), BETA * D ** -0.5),
        'ffn2_w_gu': nrm(ks[21], (L, D, 2 * D_FF), D ** -0.5),
        'ffn2_w_down': nrm(ks[22], (L, D_FF, D), BETA * D_FF ** -0.5),
    }


def reference(x, mem, ln_g, ln_b, ffn1_w_gu, ffn1_w_down, w_in, cmp_w1, cmp_w2, cmp_pos,
              conv_w, conv_b, dt_bias, a_log, d_skip, ssm_norm_g, w_branch, w_out,
              xattn_wq, xattn_wkv, xattn_wo, ffn2_w_gu, ffn2_w_down):
    for l in range(DEPTH):
        x = layer_norm(ALPHA * x + 0.5 * swiglu(x, ffn1_w_gu[l], ffn1_w_down[l]), ln_g[l, 0], ln_b[l, 0])
        mix = token_mixing(x, w_in[l], cmp_w1[l], cmp_w2[l], cmp_pos[l], conv_w[l], conv_b[l],
                           dt_bias[l], a_log[l], d_skip[l], ssm_norm_g[l], w_branch[l], w_out[l])
        x = layer_norm(ALPHA * x + mix, ln_g[l, 1], ln_b[l, 1])
        x = layer_norm(ALPHA * x + memory_cross_attention(x, mem, xattn_wq[l], xattn_wkv[l], xattn_wo[l]),
                       ln_g[l, 2], ln_b[l, 2])
        x = layer_norm(ALPHA * x + 0.5 * swiglu(x, ffn2_w_gu[l], ffn2_w_down[l]), ln_g[l, 3], ln_b[l, 3])
    return x
```

```cpp
#include <hip/hip_runtime.h>
#include <hip/hip_cooperative_groups.h>
#include <cstdio>
#include <cstdint>
namespace cg = cooperative_groups;

#define DI __device__ __forceinline__
#define LAS __attribute__((address_space(3)))
typedef unsigned short bf16_t;
typedef short bf16x8 __attribute__((ext_vector_type(8)));
typedef float f32x4 __attribute__((ext_vector_type(4)));
typedef float f32x16 __attribute__((ext_vector_type(16)));
typedef unsigned u32x4 __attribute__((ext_vector_type(4)));
typedef unsigned u32x2 __attribute__((ext_vector_type(2)));

constexpr int DM = 1024, NB = 4, SEQ = 4096, NTOK = NB * SEQ, DEPTH = 2, NMEM = 256, DFF = 2816, DIN = 7224;
constexpr int PN = 3328;
constexpr float ALPHA = 1.4142135623730951f;
constexpr float LN_EPS = 1e-5f;
constexpr int C_RQ = 0, C_RK = 128, C_RV = 256, C_RG = 512, C_DQ = 768, C_DK = 1024, C_DV = 1088, C_IQ = 1152, C_IK = 1408,
              C_NQ = 1440, C_NKC = 1696, C_NVC = 1760, C_NKS = 1824, C_NVS = 1888, C_NKW = 1952, C_NVW = 2016,
              C_SZ = 2080, C_SX = 2336, C_SB = 2592, C_SC = 2848, C_IW = 3104, C_NG = 3112, C_SDT = 3124;

constexpr int NTHREADS = 512, NWAVES = 8;
constexpr int LDS_BYTES = 152 * 1024;

constexpr size_t MiB = 1024 * 1024;
constexpr size_t WS_XF = 0;
constexpr size_t WS_XB = 64 * MiB;
constexpr size_t WS_YS = 96 * MiB;
constexpr size_t WS_BIG = 128 * MiB;
constexpr size_t WS_SLOTF = 232 * MiB;
constexpr size_t WS_WMIX = WS_SLOTF + 16 * MiB + 512 * 1024;
constexpr size_t WS_SMALL = WS_WMIX + 27 * MiB + 512 * 1024;
constexpr size_t WS_END = WS_SMALL + 8 * MiB;
constexpr size_t BIG_H = WS_BIG, BIG_PROJ = WS_BIG, BIG_GBUF = WS_BIG, BIG_MERGED = WS_BIG + 32 * MiB, BIG_QX = WS_BIG, BIG_AO = WS_BIG + 32 * MiB;
constexpr size_t W_GU = WS_SLOTF, W_DOWN = WS_SLOTF + 11 * MiB;
constexpr size_t W_IN = WS_WMIX, W_G = W_IN + (size_t)PN * 1024 * 2, W_B = W_G + 8 * MiB, W_OUT = W_B + 2 * MiB, W_Q = W_OUT + 2 * MiB,
                 W_KV = W_Q + 2 * MiB, W_O = W_KV + 4 * MiB, W_C1 = W_O + 2 * MiB, W_C2 = W_C1 + 512 * 1024, W_MIX_END = W_C2 + 16 * 1024;
static_assert(W_MIX_END <= WS_SMALL, "wmix overflow");
constexpr size_t S_MEMB = WS_SMALL, S_KVX = S_MEMB + 2 * MiB, S_TAB = S_KVX + 4 * MiB;

enum { IN_X = 0, IN_MEM, IN_LNG, IN_LNB, IN_F1GU, IN_F1DN, IN_WIN, IN_C1, IN_C2, IN_CPOS, IN_CONVW, IN_CONVB, IN_DTB, IN_ALOG, IN_DSKIP, IN_SNG,
       IN_WBR, IN_WOUT, IN_XQ, IN_XKV, IN_XO, IN_F2GU, IN_F2DN };

struct Params {
    const float* in[23];
    float* out;
    unsigned char* ws;
    int phase_lo, phase_hi;
};

DI float bf2f(bf16_t b) { return __uint_as_float(((unsigned)b) << 16); }
DI bf16_t f2bf(float f) { unsigned u = __float_as_uint(f); u += 0x7fffu + ((u >> 16) & 1u); return (bf16_t)(u >> 16); }
DI unsigned pk2(float lo, float hi) { unsigned r; asm volatile("v_cvt_pk_bf16_f32 %0, %1, %2" : "=v"(r) : "v"(lo), "v"(hi)); return r; }
DI float wave_sum(float v) {
#pragma unroll
    for (int o = 1; o < 64; o <<= 1) v += __shfl_xor(v, o);
    return v;
}
DI int launder(int t) { asm volatile("" : "+v"(t)); return t; }
DI int otid() { int t = threadIdx.x; asm volatile("" : "+v"(t)); return t; }
DI float sigmoidf_(float x) { return 1.0f / (1.0f + __expf(-x)); }
DI float siluf_(float x) { return x / (1.0f + __expf(-x)); }

namespace pg8 {
constexpr int BM = 256, BK = 64, HALF = 128, HTB = HALF * BK * 2, STAGE_BYTES = 8 * HTB, NXCD = 8, WGM = 8;
DI int lds_byte(int r, int c) { const int st = (r >> 4) * 2 + (c >> 5), rr = r & 15, cc = c & 31, ob = rr * 64 + cc * 2; return st * 1024 + (ob ^ (((ob >> 9) & 1) << 5)); }
DI void stage_rc(int b, int& R, int& C) { const int st = b / 1024, sb = b % 1024, swz = sb ^ (((sb >> 9) & 1) << 5); R = (st >> 1) * 16 + swz / 64; C = (st & 1) * 32 + (swz % 64) / 2; }
DI int perm32(int rho) { const int n = rho >> 4, i = rho & 15; return 8 * (i >> 2) + 4 * n + (i & 3); }

struct Unit { int pm, pn; long aoff, boff; int nt, aux; };
struct Gemm { const bf16_t* A; const bf16_t* Bt; int lda, ldb; };

struct TileOrder {
    int nM, nN, nwg, G, c, nt;
    DI void init(int M, int N, int K, int G_, int c_) { nM = M / BM; nN = N / BM; nwg = nM * nN; G = G_; c = c_; nt = K / BK; }
    DI bool next(int i, Unit& u) const {
        const long L = (long)i * G + c; if (L >= nwg) return false;
        int wgid = (int)L; { const int q = nwg / NXCD, r = nwg % NXCD, xcd = wgid % NXCD, off = wgid / NXCD; wgid = (xcd < r ? xcd * (q + 1) : r * (q + 1) + (xcd - r) * q) + off; }
        const int nig = WGM * nN, gid = wgid / nig, fm = gid * WGM, gsz = (nM - fm) < WGM ? (nM - fm) : WGM;
        u.pm = fm + ((wgid % nig) % gsz); u.pn = (wgid % nig) / gsz; u.aoff = 0; u.boff = 0; u.nt = nt; u.aux = 0; return true;
    }
};

template <class Epi, class Sched>
DI void gemm_phase(LAS unsigned char* lds, const Gemm g, const Sched& S, const Epi& E) {
    const int tid = threadIdx.x, wid = __builtin_amdgcn_readfirstlane(tid >> 6), lane = tid & 63, wr = wid >> 2, wc = wid & 3, fr = lane & 15, fq = lane >> 4;
    unsigned voffA[2], voffB[2];
#pragma unroll
    for (int i = 0; i < 2; ++i) { int R, C; stage_rc(tid * 16 + i * 8192, R, C); const int Rb = Epi::PERM ? ((R & ~31) + perm32(R & 31)) : R;
        voffA[i] = (unsigned)(R * g.lda + C) * 2u; voffB[i] = (unsigned)(Rb * g.ldb + C) * 2u; }
    const size_t kstep = (size_t)(BK * 2);
    const size_t hstepA = (size_t)HALF * g.lda * 2, hstepB = (size_t)HALF * g.ldb * 2;
    const size_t tstepA = 2 * hstepA, tstepB = 2 * hstepB;
    const unsigned ldsw = (unsigned)wid * 1024u;
    const int aoff = lds_byte(wr * 64 + fr, fq * 8), boff = lds_byte(wc * 32 + fr, fq * 8);
#define PG8_SA(b, h) (((b) * 2 + (h)) * HTB)
#define PG8_SB(b, h) ((4 + (b) * 2 + (h)) * HTB)
#define PG8_STAGE(bufoff, gbase, voff) do { _Pragma("unroll") for (int _i = 0; _i < 2; ++_i) \
        __builtin_amdgcn_global_load_lds((const unsigned*)((const char*)(gbase) + (voff)[_i]), (LAS unsigned*)(lds + (bufoff) + ldsw + _i * 8192), 16, 0, 0); } while (0)
#define PG8_LDA(dst, b, h) do { _Pragma("unroll") for (int m = 0; m < 4; ++m) _Pragma("unroll") for (int k = 0; k < 2; ++k) dst[m][k] = *(const LAS bf16x8*)(lds + PG8_SA(b, h) + aoff + m * 2048 + k * 1024); } while (0)
#define PG8_LDB(dst, b, h) do { _Pragma("unroll") for (int n = 0; n < 2; ++n) _Pragma("unroll") for (int k = 0; k < 2; ++k) dst[n][k] = *(const LAS bf16x8*)(lds + PG8_SB(b, h) + boff + n * 2048 + k * 1024); } while (0)
#define PG8_MMA(ai, bj, At, Bt) do { __builtin_amdgcn_s_setprio(1); _Pragma("unroll") for (int m = 0; m < 4; ++m) _Pragma("unroll") for (int n = 0; n < 2; ++n) _Pragma("unroll") for (int k = 0; k < 2; ++k) \
        acc[ai][bj][m][n] = __builtin_amdgcn_mfma_f32_16x16x32_bf16(Bt[n][k], At[m][k], acc[ai][bj][m][n], 0, 0, 0); __builtin_amdgcn_s_setprio(0); } while (0)
#define PG8_WAIT_V(n) asm volatile("s_waitcnt vmcnt(" #n ")" ::: "memory")
#define PG8_WAIT_L(n) asm volatile("s_waitcnt lgkmcnt(" #n ")" ::: "memory")
#define PG8_BAR __builtin_amdgcn_s_barrier()
#define PG8_SCHED __builtin_amdgcn_sched_barrier(0)
    Unit cur, nxt; int ui = 0;
    if (!S.next(0, cur)) return;
    f32x4 acc[2][2][4][2];
#pragma unroll
    for (int a = 0; a < 2; ++a)
#pragma unroll
        for (int b = 0; b < 2; ++b)
#pragma unroll
            for (int m = 0; m < 4; ++m)
#pragma unroll
                for (int n = 0; n < 2; ++n) acc[a][b][m][n] = (f32x4){0.f, 0.f, 0.f, 0.f};
    bf16x8 At[4][2], B0[2][2], B1[2][2];
    const char* cA = (const char*)g.A + (size_t)cur.pm * tstepA + cur.aoff; const char* cB = (const char*)g.Bt + (size_t)cur.pn * tstepB + cur.boff;
    PG8_STAGE(PG8_SB(0, 0), cB, voffB); PG8_STAGE(PG8_SA(0, 0), cA, voffA); PG8_STAGE(PG8_SB(0, 1), cB + hstepB, voffB); PG8_STAGE(PG8_SA(0, 1), cA + hstepA, voffA);
    if (wr == 1) PG8_BAR;
    PG8_WAIT_V(4); PG8_BAR;
    PG8_STAGE(PG8_SB(1, 0), cB + kstep, voffB); PG8_STAGE(PG8_SA(1, 0), cA + kstep, voffA); PG8_STAGE(PG8_SB(1, 1), cB + hstepB + kstep, voffB);
    PG8_WAIT_V(6); PG8_BAR;
    for (;;) {
        const bool has_next = S.next(ui + 1, nxt);
        const char* nA = has_next ? (const char*)g.A + (size_t)nxt.pm * tstepA + nxt.aoff : cA; const char* nB = has_next ? (const char*)g.Bt + (size_t)nxt.pn * tstepB + nxt.boff : cB;
        const int nt = cur.nt;
        for (int t = 0; t < nt; t += 2) {
            const bool last = (t == nt - 2);
            const char* a1 = cA + (size_t)(t + 1) * kstep;
            const char* a2 = last ? nA : cA + (size_t)(t + 2) * kstep; const char* b2 = last ? nB : cB + (size_t)(t + 2) * kstep;
            const char* a3 = a2 + kstep; const char* b3 = b2 + kstep;
            PG8_LDB(B0, 0, 0); PG8_SCHED; PG8_LDA(At, 0, 0); PG8_STAGE(PG8_SA(1, 1), a1 + hstepA, voffA);
            PG8_WAIT_L(8); PG8_BAR; PG8_WAIT_L(0); PG8_MMA(0, 0, At, B0); PG8_BAR; PG8_SCHED;
            PG8_LDB(B1, 0, 1); PG8_STAGE(PG8_SB(0, 0), b2, voffB);
            PG8_BAR; PG8_WAIT_L(0); PG8_MMA(0, 1, At, B1); PG8_BAR;
            PG8_LDA(At, 0, 1); PG8_STAGE(PG8_SA(0, 0), a2, voffA);
            PG8_BAR; PG8_WAIT_L(0); PG8_MMA(1, 0, At, B0); PG8_BAR; PG8_SCHED;
            PG8_STAGE(PG8_SB(0, 1), b2 + hstepB, voffB);
            PG8_WAIT_V(6); PG8_BAR; PG8_MMA(1, 1, At, B1); PG8_BAR;
            PG8_LDB(B0, 1, 0); PG8_SCHED; PG8_LDA(At, 1, 0); PG8_STAGE(PG8_SA(0, 1), a2 + hstepA, voffA);
            PG8_WAIT_L(8); PG8_BAR; PG8_WAIT_L(0); PG8_MMA(0, 0, At, B0); PG8_BAR; PG8_SCHED;
            PG8_LDB(B1, 1, 1); PG8_STAGE(PG8_SB(1, 0), b3, voffB);
            PG8_BAR; PG8_WAIT_L(0); PG8_MMA(0, 1, At, B1); PG8_BAR;
            PG8_LDA(At, 1, 1); PG8_STAGE(PG8_SA(1, 0), a3, voffA);
            PG8_BAR; PG8_WAIT_L(0); PG8_MMA(1, 0, At, B0); PG8_BAR; PG8_SCHED;
            PG8_STAGE(PG8_SB(1, 1), b3 + hstepB, voffB);
            PG8_WAIT_V(6); PG8_BAR; PG8_MMA(1, 1, At, B1); PG8_BAR;
        }
        E(acc, cur, wr, wc, fr, fq);
        if (!has_next) break;
#pragma unroll
        for (int a = 0; a < 2; ++a)
#pragma unroll
            for (int b = 0; b < 2; ++b)
#pragma unroll
                for (int m = 0; m < 4; ++m)
#pragma unroll
                    for (int n = 0; n < 2; ++n) acc[a][b][m][n] = (f32x4){0.f, 0.f, 0.f, 0.f};
        cur = nxt; cA = nA; cB = nB; ++ui;
    }
    PG8_WAIT_V(0);
    if (wr == 0) PG8_BAR;
    PG8_BAR;
#undef PG8_SA
#undef PG8_SB
#undef PG8_STAGE
#undef PG8_LDA
#undef PG8_LDB
#undef PG8_MMA
#undef PG8_WAIT_V
#undef PG8_WAIT_L
#undef PG8_BAR
#undef PG8_SCHED
}

struct EpiSwiGLU {
    static constexpr bool PERM = false;
    bf16_t* H;
    DI void operator()(const f32x4 (&acc)[2][2][4][2], const Unit& u, int wr, int wc, int fr, int fq) const {
        const int row0 = u.pm * BM + wr * 64 + fr, hc0 = u.pn * 128 + wc * 16 + fq * 4;
#pragma unroll
        for (int ai = 0; ai < 2; ++ai)
#pragma unroll
            for (int m = 0; m < 4; ++m) { bf16_t* rowp = H + (size_t)(row0 + ai * HALF + m * 16) * DFF + hc0;
#pragma unroll
                for (int bj = 0; bj < 2; ++bj) { const f32x4 gg = acc[ai][bj][m][0], uu = acc[ai][bj][m][1];
                    u32x2 w; w.x = pk2(siluf_(gg[0]) * uu[0], siluf_(gg[1]) * uu[1]); w.y = pk2(siluf_(gg[2]) * uu[2], siluf_(gg[3]) * uu[3]);
                    *(u32x2*)(rowp + bj * 64) = w; } }
    }
};
struct EpiResid {
    static constexpr bool PERM = false;
    float* X; float s;
    DI void operator()(const f32x4 (&acc)[2][2][4][2], const Unit& u, int wr, int wc, int fr, int fq) const {
        const int row0 = u.pm * BM + wr * 64 + fr, col0 = u.pn * BM + wc * 32 + 4 * fq;
#pragma unroll
        for (int ai = 0; ai < 2; ++ai)
#pragma unroll
            for (int m = 0; m < 4; ++m) { float* rowp = X + (size_t)(row0 + ai * HALF + m * 16) * DM + col0;
#pragma unroll
                for (int bj = 0; bj < 2; ++bj)
#pragma unroll
                    for (int n = 0; n < 2; ++n) { f32x4* p = (f32x4*)(rowp + bj * HALF + n * 16); const f32x4 o = *p; *p = o * ALPHA + acc[ai][bj][m][n] * s; } }
    }
};
struct EpiBf16 {
    static constexpr bool PERM = true;
    bf16_t* O; int ldc;
    DI void operator()(const f32x4 (&acc)[2][2][4][2], const Unit& u, int wr, int wc, int fr, int fq) const {
        const int row0 = u.pm * BM + wr * 64 + fr, col0 = u.pn * BM + wc * 32 + 8 * fq;
#pragma unroll
        for (int ai = 0; ai < 2; ++ai)
#pragma unroll
            for (int m = 0; m < 4; ++m) { bf16_t* rowp = O + (size_t)(row0 + ai * HALF + m * 16) * ldc + col0;
#pragma unroll
                for (int bj = 0; bj < 2; ++bj) { const f32x4 v0 = acc[ai][bj][m][0], v1 = acc[ai][bj][m][1];
                    u32x4 w; w.x = pk2(v0[0], v0[1]); w.y = pk2(v0[2], v0[3]); w.z = pk2(v1[0], v1[1]); w.w = pk2(v1[2], v1[3]);
                    *(u32x4*)(rowp + bj * HALF) = w; } }
    }
};
}

enum { MAP_ID = 0, MAP_GU = 1, MAP_IN = 2, MAP_GATE = 3 };
DI int map_col(int kind, int r) {
    if (kind == MAP_GU) { const int pn = r >> 8, c = r & 255; const int bj = c >> 7, wc = (c >> 5) & 3, n = (c >> 4) & 1, fq = (c >> 2) & 3, j = c & 3; return n * DFF + pn * 128 + bj * 64 + wc * 16 + fq * 4 + j; }
    if (kind == MAP_IN) {
        if (r < 1440) return r;
        if (r < 2080) return r + 8;
        if (r < 3104) return r + 20;
        if (r < 3112) return r - 3104 + 1440;
        if (r < 3124) return r - 3112 + 2088;
        if (r < 3128) return r;
        return -1;
    }
    if (kind == MAP_GATE) return 3128 + r;
    return r;
}
DI void cvt_item(const float* W, int K, int N, bf16_t* WT, int kind, LAS float* scr, int item, int nblk, int lane) {
    const int kb = item / nblk, nb = item % nblk, k0 = 64 * kb, n0 = 32 * nb;
    const int sc = map_col(kind, n0 + (lane & 31));
#pragma unroll 8
    for (int i = 0; i < 32; ++i) { const int kk = 2 * i + (lane >> 5); scr[kk * 33 + (lane & 31)] = sc >= 0 ? W[(size_t)(k0 + kk) * N + sc] : 0.f; }
    asm volatile("s_waitcnt lgkmcnt(0)" ::: "memory");
    const int c = lane & 7;
#pragma unroll
    for (int j = 0; j < 4; ++j) { const int n = (lane >> 3) + 8 * j; const LAS float* s = scr + (8 * c) * 33 + n;
        u32x4 o; o.x = pk2(s[0 * 33], s[1 * 33]); o.y = pk2(s[2 * 33], s[3 * 33]); o.z = pk2(s[4 * 33], s[5 * 33]); o.w = pk2(s[6 * 33], s[7 * 33]);
        *(u32x4*)(WT + (size_t)(n0 + n) * K + k0 + 8 * c) = o; }
    asm volatile("s_waitcnt lgkmcnt(0)" ::: "memory");
}
DI void cvt_matrix(const float* W, int K, int N, bf16_t* WT, int rows, int kind, LAS unsigned char* lds, int c, int G) {
    const int tid = otid(), wave = tid >> 6, gw = c * NWAVES + wave, ngw = G * NWAVES;
    LAS float* scr = (LAS float*)(lds + wave * 16384);
    const int nblk = rows / 32, nitems = (K / 64) * nblk, lane = tid & 63;
    for (int it = gw; it < nitems; it += ngw) cvt_item(W, K, N, WT, kind, scr, it, nblk, lane);
}

DI void ln_phase(float* X, bf16_t* XB, float* OUT, const float* g, const float* b, int c, int G) {
    const int tid = otid(), lane = tid & 63, gw = c * NWAVES + (tid >> 6), ngw = G * NWAVES;
    f32x4 gv[4], bv[4];
#pragma unroll
    for (int j = 0; j < 4; ++j) { gv[j] = ((const f32x4*)g)[lane + 64 * j]; bv[j] = ((const f32x4*)b)[lane + 64 * j]; }
    for (int row = gw; row < NTOK; row += ngw) {
        f32x4* xr = (f32x4*)(X + (size_t)row * DM) + lane;
        f32x4 v[4]; float s = 0.f;
#pragma unroll
        for (int j = 0; j < 4; ++j) { v[j] = xr[64 * j]; s += (v[j][0] + v[j][1]) + (v[j][2] + v[j][3]); }
        const float mean = wave_sum(s) * (1.f / DM); float s2 = 0.f;
#pragma unroll
        for (int j = 0; j < 4; ++j) { v[j] = v[j] - mean; s2 += (v[j][0] * v[j][0] + v[j][1] * v[j][1]) + (v[j][2] * v[j][2] + v[j][3] * v[j][3]); }
        const float rstd = 1.0f / sqrtf(wave_sum(s2) * (1.f / DM) + LN_EPS);
        float* orow = OUT ? OUT + (size_t)row * DM : X + (size_t)row * DM;
#pragma unroll
        for (int j = 0; j < 4; ++j) { const f32x4 o = v[j] * rstd * gv[j] + bv[j]; ((f32x4*)orow)[lane + 64 * j] = o;
            if (XB) { u32x2 w; w.x = pk2(o[0], o[1]); w.y = pk2(o[2], o[3]); ((u32x2*)(XB + (size_t)row * DM))[lane + 64 * j] = w; } }
    }
}


struct EpiKV {
    static constexpr bool PERM = true;
    bf16_t* KX; bf16_t* VT;
    DI void operator()(const f32x4 (&acc)[2][2][4][2], const pg8::Unit& u, int wr, int wc, int fr, int fq) const {
        const int row0 = wr * 64 + fr, col0 = u.pn * 256 + wc * 32 + 8 * fq;
#pragma unroll
        for (int ai = 0; ai < 2; ++ai)
#pragma unroll
            for (int m = 0; m < 4; ++m) { const int mr = row0 + ai * 128 + m * 16;
#pragma unroll
                for (int bj = 0; bj < 2; ++bj) { const f32x4 v0 = acc[ai][bj][m][0], v1 = acc[ai][bj][m][1]; const int col = col0 + bj * 128;
                    if (u.pn < 4) { u32x4 w; w.x = pk2(v0[0], v0[1]); w.y = pk2(v0[2], v0[3]); w.z = pk2(v1[0], v1[1]); w.w = pk2(v1[2], v1[3]);
                        *(u32x4*)(KX + (size_t)(u.pm * 256 + mr) * DM + col) = w; }
                    else { bf16_t* vp = VT + ((size_t)u.pm * DM + (col - DM)) * NMEM + mr;
#pragma unroll
                        for (int e = 0; e < 4; ++e) { vp[(size_t)e * NMEM] = f2bf(v0[e]); vp[(size_t)(e + 4) * NMEM] = f2bf(v1[e]); } } } }
    }
};
#define MFMA32(a, b, c) __builtin_amdgcn_mfma_f32_32x32x16_bf16((a), (b), (c), 0, 0, 0)
DI float half_max(float v) {
#pragma unroll
    for (int o = 1; o < 32; o <<= 1) v = fmaxf(v, __shfl_xor(v, o));
    return v;
}
DI float half_sum(float v) {
#pragma unroll
    for (int o = 1; o < 32; o <<= 1) v += __shfl_xor(v, o);
    return v;
}
DI int crow(int r, int hh) { return 8 * (r >> 2) + 4 * hh + (r & 3); }
DI void xattn_phase(const bf16_t* qx, const bf16_t* kx, const bf16_t* vT, bf16_t* ao, LAS unsigned char* lds, int c, int G) {
    const int tid = otid(), lane = tid & 63, wave = tid >> 6, r32 = lane & 31, hh = lane >> 5;
    LAS bf16_t* P = (LAS bf16_t*)(lds + wave * (32 * 264 * 2));
    for (int item = c * NWAVES + wave; item < 2048; item += G * NWAVES) {
        const int b = item >> 9, h = (item >> 7) & 3, t0 = (item & 127) * 32;
        const bf16_t* qrow = qx + (size_t)(b * SEQ + t0 + r32) * DM + h * 256 + hh * 8;
        const bf16_t* krow = kx + (size_t)(b * NMEM + r32) * DM + h * 256 + hh * 8;
        f32x16 S[8];
#pragma unroll
        for (int j = 0; j < 8; ++j)
#pragma unroll
            for (int r = 0; r < 16; ++r) S[j][r] = 0.f;
#pragma unroll 2
        for (int ks = 0; ks < 16; ++ks) {
            const bf16x8 a = *(const bf16x8*)(qrow + ks * 16);
#pragma unroll
            for (int j = 0; j < 8; ++j) { const bf16x8 bb = *(const bf16x8*)(krow + (size_t)j * 32 * DM + ks * 16); S[j] = MFMA32(a, bb, S[j]); }
        }
        float inv[16];
#pragma unroll
        for (int r = 0; r < 16; ++r) {
            float m = S[0][r];
#pragma unroll
            for (int j = 1; j < 8; ++j) m = fmaxf(m, S[j][r]);
            m = half_max(m);
            float sm = 0.f;
#pragma unroll
            for (int j = 0; j < 8; ++j) { const float e = __expf((S[j][r] - m) * 0.0625f); sm += e; P[crow(r, hh) * 264 + j * 32 + r32] = f2bf(e); }
            inv[r] = 1.0f / half_sum(sm);
        }
        const bf16_t* vrow = vT + ((size_t)b * DM + h * 256 + r32) * NMEM + hh * 8;
        bf16_t* orow = ao + (size_t)(b * SEQ + t0) * DM + h * 256 + r32;
#pragma unroll 1
        for (int half = 0; half < 2; ++half) {
            f32x16 O[4];
#pragma unroll
            for (int j = 0; j < 4; ++j)
#pragma unroll
                for (int r = 0; r < 16; ++r) O[j][r] = 0.f;
#pragma unroll 2
            for (int ks = 0; ks < 16; ++ks) {
                const bf16x8 a = *(const LAS bf16x8*)(P + r32 * 264 + ks * 16 + hh * 8);
#pragma unroll
                for (int j = 0; j < 4; ++j) { const bf16x8 bb = *(const bf16x8*)(vrow + (size_t)(half * 4 + j) * 32 * NMEM + ks * 16); O[j] = MFMA32(a, bb, O[j]); }
            }
#pragma unroll
            for (int r = 0; r < 16; ++r)
#pragma unroll
                for (int j = 0; j < 4; ++j) orow[(size_t)crow(r, hh) * DM + (half * 4 + j) * 32] = f2bf(O[j][r] * inv[r]);
        }
    }
}

constexpr size_t X_DVT = WS_SLOTF, X_NVST = X_DVT + 2 * MiB, X_NVWT = X_NVST + 2 * MiB;
constexpr size_t X_RST = X_NVWT + 2 * MiB;
constexpr size_t X_SST = X_RST + 2 * MiB;
constexpr size_t X_CDEC = X_SST + 8 * MiB;
constexpr size_t X_END = X_CDEC + 4096;
static_assert(X_END <= WS_WMIX, "mixer scratch overflow");
constexpr size_t S_KCMP = S_TAB + 1 * MiB, S_VCMPT = S_KCMP + 128 * 1024;
constexpr size_t T_RC = S_TAB, T_RS = T_RC + 4096 * 16 * 4, T_AC = T_RS + 4096 * 16 * 4, T_AS = T_AC + 4096 * 8 * 4, T_IC = T_AS + 4096 * 8 * 4, T_IS = T_IC + 4096 * 4 * 4;
static_assert(T_IS + 4096 * 4 * 4 <= S_KCMP && S_VCMPT + 128 * 1024 <= WS_END, "small overflow");

DI void table_phase(unsigned char* ws, int c, int G) {
    const int tid = otid();
    for (int i = c * NTHREADS + tid; i < 4096 * 28; i += G * NTHREADS) {
        const int pos = i / 28, k = i % 28; double theta; int idx, rot; float *cp, *sp;
        if (k < 16) { theta = 10000.0; idx = k; rot = 32; cp = (float*)(ws + T_RC) + pos * 16 + idx; sp = (float*)(ws + T_RS) + pos * 16 + idx; }
        else if (k < 24) { theta = 500000.0; idx = k - 16; rot = 16; cp = (float*)(ws + T_AC) + pos * 8 + idx; sp = (float*)(ws + T_AS) + pos * 8 + idx; }
        else { theta = 500000.0; idx = k - 24; rot = 8; cp = (float*)(ws + T_IC) + pos * 4 + idx; sp = (float*)(ws + T_IS) + pos * 4 + idx; }
        const float inv = (float)exp2(-2.0 * idx / rot * log2(theta));
        const float ang = (float)pos * inv;
        double rev = (double)ang * 0.15915494309189533577; rev -= rint(rev);
        const float rf = (float)rev;
        *cp = __builtin_amdgcn_cosf(rf); *sp = __builtin_amdgcn_sinf(rf);
    }
}

DI void rope_pair(bf16_t* row, int c1, int c2, float cs, float sn, float scale) {
    const float x1 = bf2f(row[c1]), x2 = bf2f(row[c2]);
    row[c1] = f2bf((x1 * cs - x2 * sn) * scale); row[c2] = f2bf((x2 * cs + x1 * sn) * scale);
}
DI void prep_phase(unsigned char* ws, LAS unsigned char* lds, int c, int G) {
    const int tid = otid();
    bf16_t* proj = (bf16_t*)(ws + BIG_PROJ);
    const float *trc = (const float*)(ws + T_RC), *trs = (const float*)(ws + T_RS), *tac = (const float*)(ws + T_AC), *tas = (const float*)(ws + T_AS), *tic = (const float*)(ws + T_IC), *tis = (const float*)(ws + T_IS);
    LAS bf16_t* tile = (LAS bf16_t*)lds;
    for (int it = c; it < NTOK / 64; it += G) {
        const int tok0 = it * 64, b = tok0 / SEQ, p0 = tok0 % SEQ;
        for (int idx = tid; idx < 64 * 260; idx += NTHREADS) {
            const int tl = idx / 260, pr = idx % 260, pos = p0 + tl; bf16_t* row = proj + (size_t)(tok0 + tl) * PN;
            if (pr < 128) { const int q = pr & 63, hd = q >> 4, i = q & 15, base = (pr < 64 ? C_RQ : C_RK) + hd * 32 + i; rope_pair(row, base, base + 16, trc[pos * 16 + i], trs[pos * 16 + i], pr < 64 ? 1.0f : 0.17677669529663687f); }
            else if (pr < 160) { const int q = pr - 128, hd = q >> 3, i = q & 7, base = C_DQ + hd * 64 + i; rope_pair(row, base, base + 8, tac[pos * 8 + i], tas[pos * 8 + i], 1.0f); }
            else if (pr < 168) { const int i = pr - 160, base = C_DK + i; rope_pair(row, base, base + 8, tac[pos * 8 + i], tas[pos * 8 + i], 1.0f); }
            else if (pr < 200) { const int q = pr - 168, hd = q >> 2, i = q & 3, base = C_IQ + hd * 32 + i; rope_pair(row, base, base + 4, tic[pos * 4 + i], tis[pos * 4 + i], 1.0f); }
            else if (pr < 204) { const int i = pr - 200, base = C_IK + i; rope_pair(row, base, base + 4, tic[pos * 4 + i], tis[pos * 4 + i], 1.0f); }
            else if (pr < 236) { const int q = pr - 204, hd = q >> 3, i = q & 7, base = C_NQ + hd * 64 + i; rope_pair(row, base, base + 8, tac[pos * 8 + i], tas[pos * 8 + i], 1.0f); }
            else { const int q = pr - 236, w = q >> 3, i = q & 7, base = (w == 0 ? C_NKC : (w == 1 ? C_NKS : C_NKW)) + i; rope_pair(row, base, base + 8, tac[pos * 8 + i], tas[pos * 8 + i], 1.0f); }
        }
        for (int m = 0; m < 3; ++m) {
            const int col = m == 0 ? C_DV : (m == 1 ? C_NVS : C_NVW); bf16_t* vT = (bf16_t*)(ws + (m == 0 ? X_DVT : (m == 1 ? X_NVST : X_NVWT)));
            __syncthreads();
            { const int tl = tid >> 3, ch = tid & 7; const u32x4 v = *(const u32x4*)(proj + (size_t)(tok0 + tl) * PN + col + ch * 8);
              LAS unsigned* d = (LAS unsigned*)(tile + tl * 66 + ch * 8); d[0] = v.x; d[1] = v.y; d[2] = v.z; d[3] = v.w; }
            __syncthreads();
            { const int d = tid >> 3, tc = tid & 7; unsigned w[4];
#pragma unroll
              for (int k = 0; k < 4; ++k) w[k] = (unsigned)tile[(tc * 8 + 2 * k) * 66 + d] | ((unsigned)tile[(tc * 8 + 2 * k + 1) * 66 + d] << 16);
              u32x4 o; o.x = w[0]; o.y = w[1]; o.z = w[2]; o.w = w[3];
              *(u32x4*)(vT + ((size_t)b * 64 + d) * SEQ + p0 + tc * 8) = o; }
        }
        __syncthreads();
    }
}

DI float gelu_tanh(float x) { const float u = 0.7978845608028654f * (x + 0.044715f * x * x * x); const float t = 1.0f - 2.0f / (1.0f + __expf(2.0f * u)); return 0.5f * x * (1.0f + t); }
DI void compress_phase(const Params& p, int l, unsigned char* ws, LAS unsigned char* lds, int c, int G) {
    const int tid = otid(), lane = tid & 63, wave = tid >> 6, r32 = lane & 31, hh = lane >> 5;
    const bf16_t* proj = (const bf16_t*)(ws + BIG_PROJ);
    LAS float* part = (LAS float*)lds;
    LAS bf16_t* hbuf = (LAS bf16_t*)(lds + 65536);
    for (int it = c; it < 64; it += G) {
        const int which = it & 1, mt = (it >> 1) & 7, b = it >> 4;
        const float* cpos = p.in[IN_CPOS] + (size_t)(l * 2 + which) * 32 * 64;
        const bf16_t* w1t = (const bf16_t*)(ws + W_C1) + (size_t)which * 64 * 2048;
        const bf16_t* w2t = (const bf16_t*)(ws + W_C2) + (size_t)which * 64 * 64;
        int cb = mt * 32 + r32; if (cb > 254) cb = 254;
        const bf16_t* src = proj + (size_t)(b * SEQ + 16 * cb) * PN + (which ? C_NVC : C_NKC);
        f32x16 acc[2];
#pragma unroll
        for (int n = 0; n < 2; ++n)
#pragma unroll
            for (int r = 0; r < 16; ++r) acc[n][r] = 0.f;
        for (int ks = wave * 16; ks < wave * 16 + 16; ++ks) {
            const int k0 = ks * 16 + hh * 8, lt = k0 >> 6, d = k0 & 63;
            const u32x4 raw = *(const u32x4*)(src + (size_t)lt * PN + d);
            const f32x4 p0 = *(const f32x4*)(cpos + lt * 64 + d), p1 = *(const f32x4*)(cpos + lt * 64 + d + 4);
            u32x4 av; av.x = pk2(__uint_as_float(raw.x << 16) + p0[0], __uint_as_float(raw.x & 0xffff0000u) + p0[1]); av.y = pk2(__uint_as_float(raw.y << 16) + p0[2], __uint_as_float(raw.y & 0xffff0000u) + p0[3]);
            av.z = pk2(__uint_as_float(raw.z << 16) + p1[0], __uint_as_float(raw.z & 0xffff0000u) + p1[1]); av.w = pk2(__uint_as_float(raw.w << 16) + p1[2], __uint_as_float(raw.w & 0xffff0000u) + p1[3]);
            const bf16x8 a = __builtin_bit_cast(bf16x8, av);
#pragma unroll
            for (int n = 0; n < 2; ++n) { const bf16x8 bb = *(const bf16x8*)(w1t + (size_t)(n * 32 + r32) * 2048 + ks * 16 + hh * 8); acc[n] = MFMA32(a, bb, acc[n]); }
        }
        __syncthreads();
#pragma unroll
        for (int n = 0; n < 2; ++n)
#pragma unroll
            for (int r = 0; r < 16; ++r) part[(wave * 32 + crow(r, hh)) * 64 + n * 32 + r32] = acc[n][r];
        __syncthreads();
        for (int e = tid; e < 32 * 64; e += NTHREADS) { float sacc = 0.f;
#pragma unroll
            for (int w = 0; w < 8; ++w) sacc += part[w * 2048 + e];
            hbuf[(e >> 6) * 72 + (e & 63)] = f2bf(gelu_tanh(sacc)); }
        __syncthreads();
        if (wave == 0) {
            f32x16 o[2];
#pragma unroll
            for (int n = 0; n < 2; ++n)
#pragma unroll
                for (int r = 0; r < 16; ++r) o[n][r] = 0.f;
#pragma unroll
            for (int ks = 0; ks < 4; ++ks) { const bf16x8 a = *(const LAS bf16x8*)(hbuf + r32 * 72 + ks * 16 + hh * 8);
#pragma unroll
                for (int n = 0; n < 2; ++n) { const bf16x8 bb = *(const bf16x8*)(w2t + (size_t)(n * 32 + r32) * 64 + ks * 16 + hh * 8); o[n] = MFMA32(a, bb, o[n]); } }
#pragma unroll
            for (int n = 0; n < 2; ++n)
#pragma unroll
                for (int r = 0; r < 16; ++r) { const int cbi = mt * 32 + crow(r, hh), col = n * 32 + r32;
                    if (which == 0) ((bf16_t*)(ws + S_KCMP))[((size_t)b * 256 + cbi) * 64 + col] = f2bf(o[n][r]);
                    else ((bf16_t*)(ws + S_VCMPT))[((size_t)b * 64 + col) * 256 + cbi] = f2bf(o[n][r]); }
        }
        __syncthreads();
    }
}

DI float ret_lg(int h) { return log1pf(-exp2f(-5.0f - (float)h)); }
DI void ret_state_phase(unsigned char* ws, int c, int G) {
    const int tid = otid(), lane = tid & 63, wave = tid >> 6, r32 = lane & 31, hh = lane >> 5;
    const bf16_t* proj = (const bf16_t*)(ws + BIG_PROJ); bf16_t* rst = (bf16_t*)(ws + X_RST);
    for (int it = c * NWAVES + wave; it < NB * 32 * 4; it += G * NWAVES) {
        const int h = it & 3, n = (it >> 2) & 31, b = it >> 7; const float lg = ret_lg(h);
        const bf16_t* base = proj + (size_t)(b * SEQ + n * 128) * PN;
        f32x16 acc[2];
#pragma unroll
        for (int q = 0; q < 2; ++q)
#pragma unroll
            for (int r = 0; r < 16; ++r) acc[q][r] = 0.f;
        for (int ks = 0; ks < 8; ++ks) {
            bf16x8 a, b0, b1;
#pragma unroll
            for (int j = 0; j < 8; ++j) { const int tok = ks * 16 + hh * 8 + j; const bf16_t* row = base + (size_t)tok * PN;
                a[j] = (short)f2bf(bf2f(row[C_RK + h * 32 + r32]) * __expf((float)(127 - tok) * lg));
                b0[j] = (short)row[C_RV + h * 64 + r32]; b1[j] = (short)row[C_RV + h * 64 + 32 + r32]; }
            acc[0] = MFMA32(a, b0, acc[0]); acc[1] = MFMA32(a, b1, acc[1]);
        }
        bf16_t* dst = rst + (size_t)it * 64 * 32;
#pragma unroll
        for (int q = 0; q < 2; ++q)
#pragma unroll
            for (int r = 0; r < 16; ++r) dst[(q * 32 + r32) * 32 + crow(r, hh)] = f2bf(acc[q][r]);
    }
}
DI void ret_scan_phase(unsigned char* ws, int c, int G) {
    const int tid = otid(); bf16_t* rst = (bf16_t*)(ws + X_RST);
    for (int e = c * NTHREADS + tid; e < NB * 4 * 2048; e += G * NTHREADS) {
        const int el = e & 2047, h = (e >> 11) & 3, b = e >> 13; const float cd = __expf(128.0f * ret_lg(h));
        float st = 0.f;
        for (int n = 0; n < 32; ++n) { bf16_t* ptr = rst + ((size_t)((b * 32 + n) * 4 + h)) * 2048 + el; const float cin = bf2f(*ptr); *ptr = f2bf(st); st = st * cd + cin; }
    }
}
DI void ret_out_phase(unsigned char* ws, LAS unsigned char* lds, int c, int G) {
    const int tid = otid(), lane = tid & 63, wave = tid >> 6, r32 = lane & 31, hh = lane >> 5;
    const bf16_t* proj = (const bf16_t*)(ws + BIG_PROJ); const bf16_t* rst = (const bf16_t*)(ws + X_RST); bf16_t* ys = (bf16_t*)(ws + WS_YS);
    LAS bf16_t* Sb = (LAS bf16_t*)lds;
    LAS float* ob = (LAS float*)(lds + 128 * 136 * 2);
    for (int it = c; it < NB * 32 * 4; it += G) {
        const int h = it & 3, n = (it >> 2) & 31, b = it >> 7; const float lg = ret_lg(h);
        const bf16_t* base = proj + (size_t)(b * SEQ + n * 128) * PN;
        const int mi = wave >> 1;
        { f32x16 sacc[2];
#pragma unroll
          for (int q = 0; q < 2; ++q)
#pragma unroll
              for (int r = 0; r < 16; ++r) sacc[q][r] = 0.f;
#pragma unroll
          for (int ks = 0; ks < 2; ++ks) { const bf16x8 a = *(const bf16x8*)(base + (size_t)(mi * 32 + r32) * PN + C_RQ + h * 32 + ks * 16 + hh * 8);
#pragma unroll
              for (int q = 0; q < 2; ++q) { const int nj = (wave & 1) * 2 + q; const bf16x8 bb = *(const bf16x8*)(base + (size_t)(nj * 32 + r32) * PN + C_RK + h * 32 + ks * 16 + hh * 8); sacc[q] = MFMA32(a, bb, sacc[q]); } }
#pragma unroll
          for (int q = 0; q < 2; ++q) { const int j = ((wave & 1) * 2 + q) * 32 + r32;
#pragma unroll
              for (int r = 0; r < 16; ++r) { const int i = mi * 32 + crow(r, hh); const float dec = i >= j ? __expf((float)(i - j) * lg) : 0.f; Sb[i * 136 + j] = f2bf(sacc[q][r] * dec); } }
        }
        __syncthreads();
        { const int ni = wave & 1; f32x16 o;
#pragma unroll
          for (int r = 0; r < 16; ++r) o[r] = 0.f;
          for (int ks = 0; ks < 8; ++ks) { const bf16x8 a = *(const LAS bf16x8*)(Sb + (mi * 32 + r32) * 136 + ks * 16 + hh * 8); bf16x8 bb;
#pragma unroll
              for (int j = 0; j < 8; ++j) bb[j] = (short)base[(size_t)(ks * 16 + hh * 8 + j) * PN + C_RV + h * 64 + ni * 32 + r32];
              o = MFMA32(a, bb, o); }
          f32x16 cr;
#pragma unroll
          for (int r = 0; r < 16; ++r) cr[r] = 0.f;
          const bf16_t* prev = rst + (size_t)it * 2048;
#pragma unroll
          for (int ks = 0; ks < 2; ++ks) { const bf16x8 a = *(const bf16x8*)(base + (size_t)(mi * 32 + r32) * PN + C_RQ + h * 32 + ks * 16 + hh * 8);
              const bf16x8 bb = *(const bf16x8*)(prev + (ni * 32 + r32) * 32 + ks * 16 + hh * 8); cr = MFMA32(a, bb, cr); }
#pragma unroll
          for (int r = 0; r < 16; ++r) { const int i = mi * 32 + crow(r, hh); ob[i * 65 + ni * 32 + r32] = o[r] + cr[r] * __expf((float)(i + 1) * lg); }
        }
        __syncthreads();
        { const int i = tid >> 2, q4 = tid & 3; float v[16], sm = 0.f;
#pragma unroll
          for (int k = 0; k < 16; ++k) { v[k] = ob[i * 65 + q4 * 16 + k]; sm += v[k]; }
          sm += __shfl_xor(sm, 1); sm += __shfl_xor(sm, 2); const float mean = sm * (1.f / 64.f); float s2 = 0.f;
#pragma unroll
          for (int k = 0; k < 16; ++k) { v[k] -= mean; s2 += v[k] * v[k]; }
          s2 += __shfl_xor(s2, 1); s2 += __shfl_xor(s2, 2); const float rstd = 1.0f / sqrtf(s2 * (1.f / 64.f) + LN_EPS);
          const bf16_t* grow = base + (size_t)i * PN + C_RG + h * 64 + q4 * 16; bf16_t* yrow = ys + (size_t)(b * SEQ + n * 128 + i) * DM + h * 64 + q4 * 16;
#pragma unroll
          for (int k = 0; k < 16; ++k) yrow[k] = f2bf(siluf_(bf2f(grow[k])) * (v[k] * rstd)); }
        __syncthreads();
    }
}

DI float softplusf_(float x) { return x > 20.f ? x : log1pf(__expf(x)); }
DI float conv_silu(const bf16_t* projb, int pos, int ch, const float* cw, const float* cb) {
    float a = cb[ch];
#pragma unroll
    for (int k = 0; k < 4; ++k) { const int pp = pos - 3 + k; if (pp >= 0) a += cw[k * 768 + ch] * bf2f(projb[(size_t)pp * PN + C_SX + ch]); }
    return siluf_(a);
}
DI void ssd_state_phase(const Params& p, int l, unsigned char* ws, LAS unsigned char* lds, int c, int G) {
    const int tid = otid(), lane = tid & 63, wave = tid >> 6, r32 = lane & 31, hh = lane >> 5;
    const bf16_t* proj = (const bf16_t*)(ws + BIG_PROJ); bf16_t* sst = (bf16_t*)(ws + X_SST); float* cdec = (float*)(ws + X_CDEC);
    const float* cw = p.in[IN_CONVW] + (size_t)l * 4 * 768; const float* cb = p.in[IN_CONVB] + (size_t)l * 768;
    LAS bf16_t* XT = (LAS bf16_t*)lds;
    LAS bf16_t* BT = (LAS bf16_t*)(lds + 64 * 136 * 2);
    LAS float* dtv = (LAS float*)(lds + 192 * 136 * 2);
    for (int it = c; it < NB * 32 * 4; it += G) {
        const int h = it & 3, ch = (it >> 2) & 31, b = it >> 7, g = h >> 1;
        const bf16_t* projb = proj + (size_t)b * SEQ * PN; const int pos0 = ch * 128;
        if (tid < 128) { const float dt = softplusf_(bf2f(projb[(size_t)(pos0 + tid) * PN + C_SDT + h]) + p.in[IN_DTB][l * 4 + h]); dtv[tid] = dt; dtv[128 + tid] = -__expf(p.in[IN_ALOG][l * 4 + h]) * dt; }
        __syncthreads();
        if (tid < 128) { float a = 0.f; for (int j = 0; j <= tid; ++j) a += dtv[128 + j]; dtv[256 + tid] = a; }
        __syncthreads();
        const float alast = dtv[256 + 127];
        if (tid == 0) cdec[(b * 32 + ch) * 4 + h] = __expf(alast);
        { const int pp = tid & 63, lg8 = tid >> 6;
          for (int k = 0; k < 16; ++k) { const int ll = lg8 * 16 + k; const float xs = conv_silu(projb, pos0 + ll, h * 64 + pp, cw, cb); XT[pp * 136 + ll] = f2bf(xs * dtv[ll] * __expf(alast - dtv[256 + ll])); } }
        { const int n = tid & 127, lg4 = tid >> 7;
          for (int k = 0; k < 32; ++k) { const int ll = lg4 * 32 + k; BT[n * 136 + ll] = f2bf(conv_silu(projb, pos0 + ll, 256 + g * 128 + n, cw, cb)); } }
        __syncthreads();
        { const int mi = wave >> 2, ni = wave & 3; f32x16 acc;
#pragma unroll
          for (int r = 0; r < 16; ++r) acc[r] = 0.f;
#pragma unroll
          for (int ks = 0; ks < 8; ++ks) { const bf16x8 a = *(const LAS bf16x8*)(XT + (mi * 32 + r32) * 136 + ks * 16 + hh * 8); const bf16x8 bb = *(const LAS bf16x8*)(BT + (ni * 32 + r32) * 136 + ks * 16 + hh * 8); acc = MFMA32(a, bb, acc); }
          bf16_t* dst = sst + (size_t)((ch * NB + b) * 4 + h) * 8192;
#pragma unroll
          for (int r = 0; r < 16; ++r) dst[(mi * 32 + crow(r, hh)) * 128 + ni * 32 + r32] = f2bf(acc[r]); }
        __syncthreads();
    }
}
DI void ssd_scan_phase(unsigned char* ws, int c, int G) {
    const int tid = otid(); bf16_t* sst = (bf16_t*)(ws + X_SST); const float* cdec = (const float*)(ws + X_CDEC);
    for (int e = c * NTHREADS + tid; e < NB * 4 * 8192; e += G * NTHREADS) {
        const int el = e & 8191, h = (e >> 13) & 3, b = e >> 15; float st = 0.f;
        for (int ch = 0; ch < 32; ++ch) { bf16_t* ptr = sst + (size_t)((ch * NB + b) * 4 + h) * 8192 + el; const float cin = bf2f(*ptr); *ptr = f2bf(st); st = st * cdec[(b * 32 + ch) * 4 + h] + cin; }
    }
}
DI void ssd_out_phase(const Params& p, int l, unsigned char* ws, LAS unsigned char* lds, int c, int G) {
    const int tid = otid(), lane = tid & 63, wave = tid >> 6, r32 = lane & 31, hh = lane >> 5;
    const bf16_t* proj = (const bf16_t*)(ws + BIG_PROJ); const bf16_t* sst = (const bf16_t*)(ws + X_SST); bf16_t* ys = (bf16_t*)(ws + WS_YS);
    const float* cw = p.in[IN_CONVW] + (size_t)l * 4 * 768; const float* cb = p.in[IN_CONVB] + (size_t)l * 768;
    LAS bf16_t* Cn = (LAS bf16_t*)lds;
    LAS bf16_t* Bn = (LAS bf16_t*)(lds + 34816);
    LAS bf16_t* XT = (LAS bf16_t*)(lds + 69632);
    LAS bf16_t* xsn = (LAS bf16_t*)(lds + 87040);
    LAS bf16_t* yb = (LAS bf16_t*)(lds + 103936);
    LAS float* dtv = (LAS float*)(lds + 138752);
    for (int it = c; it < NB * 32 * 2; it += G) {
        const int g = it & 1, ch = (it >> 1) & 31, b = it >> 6;
        const bf16_t* projb = proj + (size_t)b * SEQ * PN; const int pos0 = ch * 128;
        if (tid < 256) { const int hd = tid >> 7, ll = tid & 127, h = 2 * g + hd; const float dt = softplusf_(bf2f(projb[(size_t)(pos0 + ll) * PN + C_SDT + h]) + p.in[IN_DTB][l * 4 + h]); dtv[tid] = dt; dtv[256 + tid] = -__expf(p.in[IN_ALOG][l * 4 + h]) * dt; }
        __syncthreads();
        if (tid < 256) { const int hd = tid >> 7, ll = tid & 127; float a = 0.f; for (int j = 0; j <= ll; ++j) a += dtv[256 + hd * 128 + j]; dtv[512 + tid] = a; }
        { const int n = tid & 127, lg4 = tid >> 7;
          for (int k = 0; k < 32; ++k) { const int ll = lg4 * 32 + k; Bn[ll * 136 + n] = f2bf(conv_silu(projb, pos0 + ll, 256 + g * 128 + n, cw, cb)); Cn[ll * 136 + n] = f2bf(conv_silu(projb, pos0 + ll, 512 + g * 128 + n, cw, cb)); } }
        __syncthreads();
        const int mi = wave >> 1;
        f32x16 cbt[2];
#pragma unroll
        for (int q = 0; q < 2; ++q)
#pragma unroll
            for (int r = 0; r < 16; ++r) cbt[q][r] = 0.f;
#pragma unroll
        for (int ks = 0; ks < 8; ++ks) { const bf16x8 a = *(const LAS bf16x8*)(Cn + (mi * 32 + r32) * 136 + ks * 16 + hh * 8);
#pragma unroll
            for (int q = 0; q < 2; ++q) { const bf16x8 bb = *(const LAS bf16x8*)(Bn + (((wave & 1) * 2 + q) * 32 + r32) * 136 + ks * 16 + hh * 8); cbt[q] = MFMA32(a, bb, cbt[q]); } }
        __syncthreads();
#pragma unroll 1
        for (int hd = 0; hd < 2; ++hd) {
            const int h = 2 * g + hd; LAS float* acs = dtv + 512 + hd * 128; LAS float* dth = dtv + hd * 128;
            { const int pp = tid & 63, lg8 = tid >> 6;
              for (int k = 0; k < 16; ++k) { const int ll = lg8 * 16 + k; const float xs = conv_silu(projb, pos0 + ll, h * 64 + pp, cw, cb); XT[pp * 136 + ll] = f2bf(xs * dth[ll]); xsn[ll * 66 + pp] = f2bf(xs); } }
#pragma unroll
            for (int q = 0; q < 2; ++q) { const int sidx = ((wave & 1) * 2 + q) * 32 + r32; const float as = acs[sidx];
#pragma unroll
                for (int r = 0; r < 16; ++r) { const int li = mi * 32 + crow(r, hh); const float lm = li >= sidx ? __expf(acs[li] - as) : 0.f; Bn[li * 136 + sidx] = f2bf(cbt[q][r] * lm); } }
            __syncthreads();
            { const int ni = wave & 1; f32x16 yd, yo;
#pragma unroll
              for (int r = 0; r < 16; ++r) { yd[r] = 0.f; yo[r] = 0.f; }
              const bf16_t* prev = sst + (size_t)((ch * NB + b) * 4 + h) * 8192 + (size_t)(ni * 32 + r32) * 128 + hh * 8;
#pragma unroll
              for (int ks = 0; ks < 8; ++ks) { const bf16x8 a = *(const LAS bf16x8*)(Bn + (mi * 32 + r32) * 136 + ks * 16 + hh * 8); const bf16x8 bb = *(const LAS bf16x8*)(XT + (ni * 32 + r32) * 136 + ks * 16 + hh * 8); yd = MFMA32(a, bb, yd);
                  const bf16x8 a2 = *(const LAS bf16x8*)(Cn + (mi * 32 + r32) * 136 + ks * 16 + hh * 8); const bf16x8 b2 = *(const bf16x8*)(prev + ks * 16); yo = MFMA32(a2, b2, yo); }
              const int pp = ni * 32 + r32; const float dsk = p.in[IN_DSKIP][l * 4 + h];
#pragma unroll
              for (int r = 0; r < 16; ++r) { const int li = mi * 32 + crow(r, hh); const float z = bf2f(projb[(size_t)(pos0 + li) * PN + C_SZ + h * 64 + pp]);
                  const float y = yd[r] + __expf(acs[li]) * yo[r] + bf2f(xsn[li * 66 + pp]) * dsk; yb[li * 136 + hd * 64 + pp] = f2bf(y * siluf_(z)); } }
            __syncthreads();
        }
        { const int li = tid >> 2, q4 = tid & 3; float v[32], ss = 0.f;
#pragma unroll
          for (int k = 0; k < 32; ++k) { v[k] = bf2f(yb[li * 136 + q4 * 32 + k]); ss += v[k] * v[k]; }
          ss += __shfl_xor(ss, 1); ss += __shfl_xor(ss, 2); const float rs = 1.0f / sqrtf(ss * (1.f / 128.f) + LN_EPS);
          const float* ng = p.in[IN_SNG] + (size_t)l * 256 + g * 128 + q4 * 32; bf16_t* yrow = ys + (size_t)(b * SEQ + pos0 + li) * DM + 768 + g * 128 + q4 * 32;
#pragma unroll
          for (int k = 0; k < 32; ++k) yrow[k] = f2bf(v[k] * rs * ng[k]); }
        __syncthreads();
    }
}

constexpr int L_PST = 131072, L_RED = L_PST + 20480, L_MISC = L_RED + 2304;
template <class Mask, bool SAVE_E>
DI void mqa_attn(LAS unsigned char* lds, int tid, const bf16_t* qbase, const bf16_t* kbase, int kstride, const bf16_t* vT, int vstride, int tile_lo, int tile_hi, float scale,
                 const Mask& mask, LAS float* oslot, LAS float* lsum, LAS float* esave, int estr) {
    tid = launder(tid);
    const int lane = tid & 63, wave = tid >> 6, r32 = lane & 31, hh = lane >> 5;
    LAS bf16_t* Pst = (LAS bf16_t*)(lds + L_PST + wave * 2560);
    LAS float* redm = (LAS float*)(lds + L_RED); LAS float* redl = redm + 256;
    bf16x8 qa[4];
#pragma unroll
    for (int ks = 0; ks < 4; ++ks) qa[ks] = *(const bf16x8*)(qbase + (size_t)(r32 >> 2) * PN + (r32 & 3) * 64 + ks * 16 + hh * 8);
    float m[16];
#pragma unroll
    for (int r = 0; r < 16; ++r) m[r] = -1e30f;
#pragma unroll 1
    for (int tile = tile_lo + wave; tile < tile_hi; tile += 8) {
        const int key = tile * 32 + r32; const bf16_t* kp = kbase + (size_t)key * kstride + hh * 8;
        f32x16 S;
#pragma unroll
        for (int r = 0; r < 16; ++r) S[r] = 0.f;
#pragma unroll
        for (int ks = 0; ks < 4; ++ks) S = MFMA32(qa[ks], *(const bf16x8*)(kp + ks * 16), S);
#pragma unroll
        for (int g = 0; g < 4; ++g) { const bool ok = mask(2 * g + hh, key);
#pragma unroll
            for (int i = 0; i < 4; ++i) m[4 * g + i] = ok ? fmaxf(m[4 * g + i], S[4 * g + i]) : m[4 * g + i]; }
    }
#pragma unroll
    for (int r = 0; r < 16; ++r) { m[r] = half_max(m[r]); if (r32 == 0) redm[wave * 32 + crow(r, hh)] = m[r]; }
    __syncthreads();
    LAS float* mfin = (LAS float*)(lds + L_RED + 2048);
    if (tid < 32) { float mm = redm[tid];
#pragma unroll
        for (int w = 1; w < 8; ++w) mm = fmaxf(mm, redm[w * 32 + tid]);
        mfin[tid] = mm; }
    __syncthreads();
#pragma unroll
    for (int r = 0; r < 16; ++r) m[r] = mfin[crow(r, hh)];
    float lr[16]; f32x16 O[2];
#pragma unroll
    for (int r = 0; r < 16; ++r) { lr[r] = 0.f; O[0][r] = 0.f; O[1][r] = 0.f; }
#pragma unroll 1
    for (int tile = tile_lo + wave; tile < tile_hi; tile += 8) {
        const int key = tile * 32 + r32; const bf16_t* kp = kbase + (size_t)key * kstride + hh * 8;
        f32x16 S;
#pragma unroll
        for (int r = 0; r < 16; ++r) S[r] = 0.f;
#pragma unroll
        for (int ks = 0; ks < 4; ++ks) S = MFMA32(qa[ks], *(const bf16x8*)(kp + ks * 16), S);
#pragma unroll
        for (int g = 0; g < 4; ++g) { const bool ok = mask(2 * g + hh, key);
#pragma unroll
            for (int i = 0; i < 4; ++i) { const int r = 4 * g + i; const float pe = ok ? __expf((S[r] - m[r]) * scale) : 0.f; lr[r] += pe; Pst[crow(r, hh) * 40 + r32] = f2bf(pe);
                if (SAVE_E) esave[crow(r, hh) * estr + key] = pe; } }
#pragma unroll
        for (int ks = 0; ks < 2; ++ks) { const bf16x8 a = *(const LAS bf16x8*)(Pst + r32 * 40 + ks * 16 + hh * 8);
#pragma unroll
            for (int n = 0; n < 2; ++n) O[n] = MFMA32(a, *(const bf16x8*)(vT + (size_t)(n * 32 + r32) * vstride + tile * 32 + ks * 16 + hh * 8), O[n]); }
    }
#pragma unroll
    for (int r = 0; r < 16; ++r) { lr[r] = half_sum(lr[r]); if (r32 == 0) redl[wave * 32 + crow(r, hh)] = lr[r]; }
    __syncthreads();
    LAS float* part = (LAS float*)lds;
#pragma unroll
    for (int n = 0; n < 2; ++n)
#pragma unroll
        for (int r = 0; r < 16; ++r) part[(wave * 32 + crow(r, hh)) * 64 + n * 32 + r32] = O[n][r];
    __syncthreads();
    { const int row = tid >> 4, d4 = (tid & 15) * 4; f32x4 a = {0.f, 0.f, 0.f, 0.f}; float L = 0.f;
#pragma unroll
      for (int w = 0; w < 8; ++w) { a += *(const LAS f32x4*)(part + (w * 32 + row) * 64 + d4); L += redl[w * 32 + row]; }
      const float inv = 1.0f / fmaxf(L, 1e-30f);
      *(LAS f32x4*)(oslot + row * 64 + d4) = a * inv; if ((tid & 15) == 0) lsum[row] = L; }
    __syncthreads();
}
DI void item_map(int j, int c, int G, int& b, int& t0, bool& valid) { const int idx = j * G + ((j & 1) ? (G - 1 - c) : c); valid = idx < 2048; b = idx & 3; t0 = (idx >> 2) * 8; }

DI unsigned sort_key(float f) { f = f + 0.0f; const unsigned u = __float_as_uint(f); return (u >> 31) ? ~u : (u | 0x80000000u); }
template <int NR> DI void dsa_select(const LAS float* srow, int t, int lane, unsigned& T_out, int& cut_out) {
    unsigned v[NR];
#pragma unroll
    for (int j = 0; j < NR; ++j) { const int sidx = lane + 64 * j; v[j] = sidx <= t ? sort_key(srow[sidx]) : 0u; }
    unsigned T = 0;
#pragma unroll 1
    for (int bit = 31; bit >= 0; --bit) { const unsigned cand = T | (1u << bit); int cnt = 0;
#pragma unroll
        for (int j = 0; j < NR; ++j) cnt += __popcll(__ballot(v[j] >= cand));
        if (cnt >= 256) T = cand; }
    int cgt = 0, ceq = 0;
#pragma unroll
    for (int j = 0; j < NR; ++j) { cgt += __popcll(__ballot(v[j] > T)); ceq += __popcll(__ballot(v[j] == T)); }
    int cut = 4095; const int need = 256 - cgt;
    if (ceq > need) { int cc = 0;
#pragma unroll 1
        for (int bit = 11; bit >= 0; --bit) { const int cand = cc | (1 << bit); int cnt = 0;
#pragma unroll
            for (int j = 0; j < NR; ++j) cnt += __popcll(__ballot(v[j] == T && (lane + 64 * j) < cand));
            if (cnt < need) cc = cand; }
        cut = cc; }
    T_out = T; cut_out = cut;
}
struct DsaMask { int t0; const LAS float* sc; const LAS unsigned* thr; const LAS int* cut;
    DI bool operator()(int tl, int key) const { const unsigned u = sort_key(sc[tl * 4096 + key]), T = thr[tl]; return key <= t0 + tl && (u > T || (u == T && key <= cut[tl])); } };
DI void dsa_phase(unsigned char* ws, LAS unsigned char* lds, int c, int G) {
    const int tid = otid(), lane = tid & 63, wave = tid >> 6, r32 = lane & 31, hh = lane >> 5;
    const bf16_t* proj = (const bf16_t*)(ws + BIG_PROJ); bf16_t* ys = (bf16_t*)(ws + WS_YS);
    LAS float* sc = (LAS float*)lds; LAS unsigned* thr = (LAS unsigned*)(lds + L_MISC); LAS int* cut = (LAS int*)(lds + L_MISC + 64); LAS float* lsum = (LAS float*)(lds + L_MISC + 128);
    LAS float* oslot = (LAS float*)(lds + 65536);
    const int rounds = (2048 + G - 1) / G;
    for (int j = 0; j < rounds; ++j) {
        int b, t0; bool valid; item_map(j, c, G, b, t0, valid); if (!valid) continue;
        const bf16_t* projb = proj + (size_t)b * SEQ * PN; const int nt = t0 / 32 + 1;
        {
            const int tq = launder(tid), lane = tq & 63, wave = tq >> 6, r32 = lane & 31, hh = lane >> 5;
            bf16x8 ia[2][2]; float w[2][4][4];
#pragma unroll
            for (int mt = 0; mt < 2; ++mt) {
#pragma unroll
                for (int ks = 0; ks < 2; ++ks) ia[mt][ks] = *(const bf16x8*)(projb + (size_t)(t0 + mt * 4 + (r32 >> 3)) * PN + C_IQ + (r32 & 7) * 32 + ks * 16 + hh * 8);
#pragma unroll
                for (int g = 0; g < 4; ++g)
#pragma unroll
                    for (int i = 0; i < 4; ++i) w[mt][g][i] = bf2f(projb[(size_t)(t0 + mt * 4 + g) * PN + C_IW + 4 * hh + i]) * 0.0625f;
            }
            for (int tile = wave; tile < nt; tile += 8) {
                const int key = tile * 32 + r32; const bf16_t* kp = projb + (size_t)key * PN + C_IK + hh * 8;
                const bf16x8 b0 = *(const bf16x8*)kp, b1 = *(const bf16x8*)(kp + 16);
#pragma unroll
                for (int mt = 0; mt < 2; ++mt) { f32x16 a;
#pragma unroll
                    for (int r = 0; r < 16; ++r) a[r] = 0.f;
                    a = MFMA32(ia[mt][0], b0, a); a = MFMA32(ia[mt][1], b1, a);
#pragma unroll
                    for (int g = 0; g < 4; ++g) { float v = 0.f;
#pragma unroll
                        for (int i = 0; i < 4; ++i) v += w[mt][g][i] * fmaxf(a[4 * g + i], 0.f);
                        v += __shfl_xor(v, 32);
                        if (hh == mt) sc[(mt * 4 + g) * 4096 + key] = v; } }
            }
        }
        __syncthreads();
        { const int tq = launder(tid), lane = tq & 63, wave = tq >> 6; const int t = t0 + wave; unsigned T; int cu; const LAS float* srow = sc + wave * 4096;
          if (t < 256) { T = 0u; cu = 4095; }
          else if (t < 1024) dsa_select<16>(srow, t, lane, T, cu);
          else if (t < 2048) dsa_select<32>(srow, t, lane, T, cu);
          else if (t < 3072) dsa_select<48>(srow, t, lane, T, cu);
          else dsa_select<64>(srow, t, lane, T, cu);
          if (lane == 0) { thr[wave] = T; cut[wave] = cu; } }
        __syncthreads();
        DsaMask mk{t0, sc, thr, cut};
        mqa_attn<DsaMask, false>(lds, tid, projb + (size_t)t0 * PN + C_DQ, projb + C_DK, PN, (const bf16_t*)(ws + X_DVT) + (size_t)b * 64 * SEQ, SEQ, 0, nt, 0.125f, mk, oslot, lsum, nullptr, 0);
        { const int row = tid >> 4, d4 = (tid & 15) * 4; const f32x4 o = *(const LAS f32x4*)(oslot + row * 64 + d4); u32x2 wv; wv.x = pk2(o[0], o[1]); wv.y = pk2(o[2], o[3]);
          *(u32x2*)(ys + (size_t)(b * SEQ + t0 + (row >> 2)) * DM + 256 + (row & 3) * 64 + d4) = wv; }
        __syncthreads();
    }
}

struct CmpMask { int t0; DI bool operator()(int tl, int key) const { return key <= 254 && 16 * key + 31 <= t0 + tl; } };
struct SelMask { int t0; const LAS unsigned* sel; DI bool operator()(int tl, int key) const { const int blk = key >> 6; return key <= t0 + tl && ((sel[tl * 2 + (blk >> 5)] >> (blk & 31)) & 1u); } };
struct WinMask { int t0; DI bool operator()(int tl, int key) const { const int t = t0 + tl; return key <= t && t - key < 512; } };
DI void nsa_phase(unsigned char* ws, LAS unsigned char* lds, int c, int G) {
    const int tid = otid(), lane = tid & 63, wave = tid >> 6;
    const bf16_t* proj = (const bf16_t*)(ws + BIG_PROJ); bf16_t* ys = (bf16_t*)(ws + WS_YS);
    LAS float* esave = (LAS float*)(lds + 65536);
    LAS float* OC = (LAS float*)(lds + 102400); LAS float* OS = OC + 2048; LAS float* OW = OS + 2048;
    LAS unsigned* sel = (LAS unsigned*)(lds + L_MISC); LAS float* lsum = (LAS float*)(lds + L_MISC + 128); LAS float* lsum2 = (LAS float*)(lds + L_MISC + 256);
    LAS float* impv = (LAS float*)(lds + 127488);
    const int rounds = (2048 + G - 1) / G;
    for (int j = 0; j < rounds; ++j) {
        int b, t0; bool valid; item_map(j, c, G, b, t0, valid); if (!valid) continue;
        const bf16_t* projb = proj + (size_t)b * SEQ * PN; const int nt = t0 / 32 + 1; const bf16_t* qb = projb + (size_t)t0 * PN + C_NQ;
        CmpMask cm{t0};
        mqa_attn<CmpMask, true>(lds, tid, qb, (const bf16_t*)(ws + S_KCMP) + (size_t)b * 256 * 64, 64, (const bf16_t*)(ws + S_VCMPT) + (size_t)b * 64 * 256, 256, 0, 8, 0.125f, cm, OC, lsum, esave, 264);
        {
            const int tl = wave, jb = lane, t = t0 + tl, cur = t >> 6;
            float inv[4];
#pragma unroll
            for (int hd = 0; hd < 4; ++hd) inv[hd] = 1.0f / fmaxf(lsum[tl * 4 + hd], 1e-30f);
            float imp = 0.f;
#pragma unroll
            for (int k = -1; k < 4; ++k) { const int ci = 4 * jb + k; if (ci >= 0 && ci < 255) { float pc = 0.f;
#pragma unroll
                    for (int hd = 0; hd < 4; ++hd) pc += esave[(tl * 4 + hd) * 264 + ci] * inv[hd];
                    imp += (k == -1 || k == 3) ? 0.5f * pc : pc; } }
            const bool forced = jb == 0 || jb == cur || jb == cur - 1, adm = jb <= cur;
            const float val = adm ? (forced ? __builtin_inff() : imp) : -__builtin_inff();
            impv[tl * 64 + jb] = val;
            int rank = 0;
            for (int q = 0; q < 64; ++q) { const float o = impv[tl * 64 + q]; rank += (o > val || (o == val && q < jb)) ? 1 : 0; }
            const unsigned long long bal = __ballot(rank < 16);
            if (lane == 0) { sel[tl * 2] = (unsigned)bal; sel[tl * 2 + 1] = (unsigned)(bal >> 32); }
        }
        __syncthreads();
        SelMask sm{t0, sel};
        mqa_attn<SelMask, false>(lds, tid, qb, projb + C_NKS, PN, (const bf16_t*)(ws + X_NVST) + (size_t)b * 64 * SEQ, SEQ, 0, nt, 0.125f, sm, OS, lsum2, nullptr, 0);
        WinMask wm{t0}; const int tlo = (t0 > 511 ? t0 - 511 : 0) >> 5;
        mqa_attn<WinMask, false>(lds, tid, qb, projb + C_NKW, PN, (const bf16_t*)(ws + X_NVWT) + (size_t)b * 64 * SEQ, SEQ, tlo, nt, 0.125f, wm, OW, lsum2, nullptr, 0);
        { const int row = tid >> 4, d4 = (tid & 15) * 4, tl = row >> 2, hd = row & 3; const bf16_t* gp = projb + (size_t)(t0 + tl) * PN + C_NG + hd * 3;
          const float g0 = sigmoidf_(bf2f(gp[0])), g1 = sigmoidf_(bf2f(gp[1])), g2 = sigmoidf_(bf2f(gp[2]));
          const f32x4 o = *(const LAS f32x4*)(OC + row * 64 + d4) * g0 + *(const LAS f32x4*)(OS + row * 64 + d4) * g1 + *(const LAS f32x4*)(OW + row * 64 + d4) * g2;
          u32x2 wv; wv.x = pk2(o[0], o[1]); wv.y = pk2(o[2], o[3]);
          *(u32x2*)(ys + (size_t)(b * SEQ + t0 + tl) * DM + 512 + hd * 64 + d4) = wv; }
        __syncthreads();
    }
}

struct MergeOrder {
    int G, c; long a_ys, b_wb;
    DI bool next(int i, pg8::Unit& u) const {
        const int tile = c + (i >> 3) * G; if (tile >= 256) return false;
        const int sub = i & 7, b = sub >> 1, kind = sub & 1; u.pm = tile >> 2; u.pn = tile & 3; u.aux = sub;
        if (kind == 0) { u.aoff = 0; u.boff = (long)b * 1024 * 1024 * 2; u.nt = 16; } else { u.aoff = a_ys + b * 512; u.boff = b_wb + b * 512; u.nt = 4; }
        return true;
    }
};
struct EpiMerge {
    static constexpr bool PERM = true;
    bf16_t* gbuf; bf16_t* merged;
    DI void operator()(const f32x4 (&acc)[2][2][4][2], const pg8::Unit& u, int wr, int wc, int fr, int fq) const {
        const int row0 = u.pm * 256 + wr * 64 + fr, col0 = u.pn * 256 + wc * 32 + 8 * fq; const int kind = u.aux & 1, b = u.aux >> 1;
#pragma unroll
        for (int ai = 0; ai < 2; ++ai)
#pragma unroll
            for (int m = 0; m < 4; ++m) { const size_t ro = (size_t)(row0 + ai * 128 + m * 16) * DM + col0;
#pragma unroll
                for (int bj = 0; bj < 2; ++bj) { const f32x4 v0 = acc[ai][bj][m][0], v1 = acc[ai][bj][m][1]; const size_t off = ro + bj * 128;
                    if (kind == 0) { u32x4 w; w.x = pk2(sigmoidf_(v0[0]), sigmoidf_(v0[1])); w.y = pk2(sigmoidf_(v0[2]), sigmoidf_(v0[3])); w.z = pk2(sigmoidf_(v1[0]), sigmoidf_(v1[1])); w.w = pk2(sigmoidf_(v1[2]), sigmoidf_(v1[3]));
                        *(u32x4*)(gbuf + off) = w; }
                    else { const u32x4 gq = *(const u32x4*)(gbuf + off); u32x4 pq = {0u, 0u, 0u, 0u}; if (b > 0) pq = *(const u32x4*)(merged + off);
                        float r[8];
                        r[0] = __uint_as_float(gq.x << 16) * v0[0] + __uint_as_float(pq.x << 16); r[1] = __uint_as_float(gq.x & 0xffff0000u) * v0[1] + __uint_as_float(pq.x & 0xffff0000u);
                        r[2] = __uint_as_float(gq.y << 16) * v0[2] + __uint_as_float(pq.y << 16); r[3] = __uint_as_float(gq.y & 0xffff0000u) * v0[3] + __uint_as_float(pq.y & 0xffff0000u);
                        r[4] = __uint_as_float(gq.z << 16) * v1[0] + __uint_as_float(pq.z << 16); r[5] = __uint_as_float(gq.z & 0xffff0000u) * v1[1] + __uint_as_float(pq.z & 0xffff0000u);
                        r[6] = __uint_as_float(gq.w << 16) * v1[2] + __uint_as_float(pq.w << 16); r[7] = __uint_as_float(gq.w & 0xffff0000u) * v1[3] + __uint_as_float(pq.w & 0xffff0000u);
                        u32x4 w; w.x = pk2(r[0], r[1]); w.y = pk2(r[2], r[3]); w.z = pk2(r[4], r[5]); w.w = pk2(r[6], r[7]);
                        *(u32x4*)(merged + off) = w; } } }
    }
};


DI void cvt_wmix(const Params& p, int l, LAS unsigned char* lds, int c, int G) {
    unsigned char* ws = p.ws;
    cvt_matrix(p.in[IN_WIN] + (size_t)l * DM * DIN, DM, DIN, (bf16_t*)(ws + W_IN), PN, MAP_IN, lds, c, G);
    cvt_matrix(p.in[IN_WIN] + (size_t)l * DM * DIN, DM, DIN, (bf16_t*)(ws + W_G), 4096, MAP_GATE, lds, c, G);
    cvt_matrix(p.in[IN_WBR] + (size_t)l * DM * DM, DM, DM, (bf16_t*)(ws + W_B), DM, MAP_ID, lds, c, G);
    cvt_matrix(p.in[IN_WOUT] + (size_t)l * DM * DM, DM, DM, (bf16_t*)(ws + W_OUT), DM, MAP_ID, lds, c, G);
    cvt_matrix(p.in[IN_XQ] + (size_t)l * DM * DM, DM, DM, (bf16_t*)(ws + W_Q), DM, MAP_ID, lds, c, G);
    cvt_matrix(p.in[IN_XKV] + (size_t)l * DM * 2 * DM, DM, 2 * DM, (bf16_t*)(ws + W_KV), 2 * DM, MAP_ID, lds, c, G);
    cvt_matrix(p.in[IN_XO] + (size_t)l * DM * DM, DM, DM, (bf16_t*)(ws + W_O), DM, MAP_ID, lds, c, G);
    for (int i = 0; i < 2; ++i) {
        cvt_matrix(p.in[IN_C1] + (size_t)(l * 2 + i) * 2048 * 64, 2048, 64, (bf16_t*)(ws + W_C1) + (size_t)i * 64 * 2048, 64, MAP_ID, lds, c, G);
        cvt_matrix(p.in[IN_C2] + (size_t)(l * 2 + i) * 64 * 64, 64, 64, (bf16_t*)(ws + W_C2) + (size_t)i * 64 * 64, 64, MAP_ID, lds, c, G);
    }
}

template <int l> DI void layer_body(const Params& p, cg::grid_group& grid, LAS unsigned char* lds, int c, int G) {
    unsigned char* ws = p.ws;
    float* xf = (float*)(ws + WS_XF); bf16_t* xb = (bf16_t*)(ws + WS_XB);

        const float* lng = p.in[IN_LNG] + (size_t)l * 4 * DM; const float* lnb = p.in[IN_LNB] + (size_t)l * 4 * DM;
        { pg8::TileOrder S; S.init(NTOK, 2 * DFF, DM, G, c); pg8::Gemm g{xb, (const bf16_t*)(ws + W_GU), DM, DM}; pg8::EpiSwiGLU E{(bf16_t*)(ws + BIG_H)}; pg8::gemm_phase(lds, g, S, E); }
        grid.sync();
        { pg8::TileOrder S; S.init(NTOK, DM, DFF, G, c); pg8::Gemm g{(const bf16_t*)(ws + BIG_H), (const bf16_t*)(ws + W_DOWN), DFF, DFF}; pg8::EpiResid E{xf, 0.5f}; pg8::gemm_phase(lds, g, S, E); }
        grid.sync();
        ln_phase(xf, xb, nullptr, lng, lnb, c, G);
        grid.sync();
        { pg8::TileOrder S; S.init(NTOK, PN, DM, G, c); pg8::Gemm g{xb, (const bf16_t*)(ws + W_IN), DM, DM}; pg8::EpiBf16 E{(bf16_t*)(ws + BIG_PROJ), PN}; pg8::gemm_phase(lds, g, S, E); }
        grid.sync();
        prep_phase(ws, lds, c, G);
        grid.sync();
        compress_phase(p, l, ws, lds, c, G);
        ret_state_phase(ws, c, G);
        ssd_state_phase(p, l, ws, lds, c, G);
        grid.sync();
        ret_scan_phase(ws, c, G);
        ssd_scan_phase(ws, c, G);
        grid.sync();
        ret_out_phase(ws, lds, c, G);
        ssd_out_phase(p, l, ws, lds, c, G);
        dsa_phase(ws, lds, c, G);
        nsa_phase(ws, lds, c, G);
        grid.sync();
        { MergeOrder S{G, c, (long)WS_YS - (long)WS_XB, (long)W_B - (long)W_G}; pg8::Gemm g{xb, (const bf16_t*)(ws + W_G), DM, DM}; EpiMerge E{(bf16_t*)(ws + BIG_GBUF), (bf16_t*)(ws + BIG_MERGED)}; pg8::gemm_phase(lds, g, S, E); }
        grid.sync();
        { pg8::TileOrder S; S.init(NTOK, DM, DM, G, c); pg8::Gemm g{(const bf16_t*)(ws + BIG_MERGED), (const bf16_t*)(ws + W_OUT), DM, DM}; pg8::EpiResid E{xf, 1.0f}; pg8::gemm_phase(lds, g, S, E); }
        grid.sync();
        ln_phase(xf, xb, nullptr, lng + DM, lnb + DM, c, G);
        cvt_matrix(p.in[IN_F2GU] + (size_t)l * DM * 2 * DFF, DM, 2 * DFF, (bf16_t*)(ws + W_GU), 2 * DFF, MAP_GU, lds, c, G);
        cvt_matrix(p.in[IN_F2DN] + (size_t)l * DFF * DM, DFF, DM, (bf16_t*)(ws + W_DOWN), DM, MAP_ID, lds, c, G);
        grid.sync();
        { pg8::TileOrder S; S.init(NTOK, DM, DM, G, c); pg8::Gemm g{xb, (const bf16_t*)(ws + W_Q), DM, DM}; pg8::EpiBf16 E{(bf16_t*)(ws + BIG_QX), DM}; pg8::gemm_phase(lds, g, S, E); }
        { pg8::TileOrder S; S.init(NB * NMEM, 2 * DM, DM, G, c); pg8::Gemm g{(const bf16_t*)(ws + S_MEMB), (const bf16_t*)(ws + W_KV), DM, DM}; EpiKV E{(bf16_t*)(ws + S_KVX), (bf16_t*)(ws + S_KVX + 2 * MiB)}; pg8::gemm_phase(lds, g, S, E); }
        grid.sync();
        xattn_phase((const bf16_t*)(ws + BIG_QX), (const bf16_t*)(ws + S_KVX), (const bf16_t*)(ws + S_KVX + 2 * MiB), (bf16_t*)(ws + BIG_AO), lds, c, G);
        grid.sync();
        { pg8::TileOrder S; S.init(NTOK, DM, DM, G, c); pg8::Gemm g{(const bf16_t*)(ws + BIG_AO), (const bf16_t*)(ws + W_O), DM, DM}; pg8::EpiResid E{xf, 1.0f}; pg8::gemm_phase(lds, g, S, E); }
        grid.sync();
        ln_phase(xf, xb, nullptr, lng + 2 * DM, lnb + 2 * DM, c, G);
        grid.sync();
        { pg8::TileOrder S; S.init(NTOK, 2 * DFF, DM, G, c); pg8::Gemm g{xb, (const bf16_t*)(ws + W_GU), DM, DM}; pg8::EpiSwiGLU E{(bf16_t*)(ws + BIG_H)}; pg8::gemm_phase(lds, g, S, E); }
        grid.sync();
        { pg8::TileOrder S; S.init(NTOK, DM, DFF, G, c); pg8::Gemm g{(const bf16_t*)(ws + BIG_H), (const bf16_t*)(ws + W_DOWN), DFF, DFF}; pg8::EpiResid E{xf, 0.5f}; pg8::gemm_phase(lds, g, S, E); }
        grid.sync();
        ln_phase(xf, xb, l == DEPTH - 1 ? p.out : nullptr, lng + 3 * DM, lnb + 3 * DM, c, G);
        if (l + 1 < DEPTH) {
            cvt_matrix(p.in[IN_F1GU] + (size_t)(l + 1) * DM * 2 * DFF, DM, 2 * DFF, (bf16_t*)(ws + W_GU), 2 * DFF, MAP_GU, lds, c, G);
            cvt_matrix(p.in[IN_F1DN] + (size_t)(l + 1) * DFF * DM, DFF, DM, (bf16_t*)(ws + W_DOWN), DM, MAP_ID, lds, c, G);
            cvt_wmix(p, l + 1, lds, c, G);
        }
        grid.sync();
}

__global__ void __launch_bounds__(NTHREADS) mega(Params p) {
    extern __shared__ __attribute__((aligned(16))) unsigned char lds_raw[];
    LAS unsigned char* lds = (LAS unsigned char*)lds_raw;
    cg::grid_group grid = cg::this_grid();
    const int G = gridDim.x, c = blockIdx.x;
    unsigned char* ws = p.ws;
    float* xf = (float*)(ws + WS_XF); bf16_t* xb = (bf16_t*)(ws + WS_XB);

    {
        const f32x4* xi = (const f32x4*)p.in[IN_X]; const int tid = otid();
        for (size_t i = (size_t)c * NTHREADS + tid; i < (size_t)NTOK * DM / 4; i += (size_t)G * NTHREADS) { const f32x4 v = xi[i]; ((f32x4*)xf)[i] = v; u32x2 w; w.x = pk2(v[0], v[1]); w.y = pk2(v[2], v[3]); ((u32x2*)xb)[i] = w; }
        cvt_matrix(p.in[IN_F1GU], DM, 2 * DFF, (bf16_t*)(ws + W_GU), 2 * DFF, MAP_GU, lds, c, G);
        cvt_matrix(p.in[IN_F1DN], DFF, DM, (bf16_t*)(ws + W_DOWN), DM, MAP_ID, lds, c, G);
        cvt_wmix(p, 0, lds, c, G);
        table_phase(ws, c, G);
        const f32x4* mi = (const f32x4*)p.in[IN_MEM]; bf16_t* memb = (bf16_t*)(ws + S_MEMB);
        for (size_t i = (size_t)c * NTHREADS + tid; i < (size_t)NB * NMEM * DM / 4; i += (size_t)G * NTHREADS) { const f32x4 v = mi[i]; u32x2 w; w.x = pk2(v[0], v[1]); w.y = pk2(v[2], v[3]); ((u32x2*)memb)[i] = w; }
    }
    grid.sync();
    layer_body<0>(p, grid, lds, c, G);
    layer_body<1>(p, grid, lds, c, G);
}

extern "C" void kernel_launch(void* const* d_in, const int* in_sizes, int n_in, void* d_out, int out_size, void* d_ws, size_t ws_size, hipStream_t stream) {
    static int grid = 0;
    if (grid == 0) {
        if (n_in != 23 || out_size != NTOK * DM || ws_size < WS_END) { fprintf(stderr, "kernel_launch: unexpected shapes (n_in %d out %d ws %zu need %zu)\n", n_in, out_size, ws_size, (size_t)WS_END); grid = -1; return; }
        int dev = 0, cus = 0, per_cu = 0;
        hipGetDevice(&dev); hipDeviceGetAttribute(&cus, hipDeviceAttributeMultiprocessorCount, dev);
        if (hipFuncSetAttribute((const void*)mega, hipFuncAttributeMaxDynamicSharedMemorySize, LDS_BYTES) != hipSuccess) { fprintf(stderr, "kernel_launch: hipFuncSetAttribute failed\n"); grid = -1; return; }
        if (hipOccupancyMaxActiveBlocksPerMultiprocessor(&per_cu, (const void*)mega, NTHREADS, LDS_BYTES) != hipSuccess || per_cu < 1) { fprintf(stderr, "kernel_launch: occupancy query says %d\n", per_cu); grid = -1; return; }
        grid = cus;
    }
    if (grid < 0) return;
    Params p{};
    for (int i = 0; i < 23; ++i) p.in[i] = (const float*)d_in[i];
    p.out = (float*)d_out; p.ws = (unsigned char*)d_ws; p.phase_lo = 0; p.phase_hi = 1000;
    void* args[] = {&p};
    hipError_t e = hipLaunchCooperativeKernel((const void*)mega, dim3(grid), dim3(NTHREADS), args, LDS_BYTES, stream);
    if (e != hipSuccess) fprintf(stderr, "cooperative launch failed: %s (grid %d)\n", hipGetErrorString(e), grid);
}
```

```cpp
#include <hip/hip_runtime.h>
#include <hip/hip_cooperative_groups.h>
#include <cstdio>
#include <cstdint>
namespace cg = cooperative_groups;

#define DI __device__ __forceinline__
#define LAS __attribute__((address_space(3)))
typedef unsigned short bf16_t;
typedef short bf16x8 __attribute__((ext_vector_type(8)));
typedef float f32x4 __attribute__((ext_vector_type(4)));
typedef float f32x16 __attribute__((ext_vector_type(16)));
typedef unsigned u32x4 __attribute__((ext_vector_type(4)));
typedef unsigned u32x2 __attribute__((ext_vector_type(2)));

constexpr int DM = 1024, NB = 4, SEQ = 4096, NTOK = NB * SEQ, DEPTH = 2, NMEM = 256, DFF = 2816, DIN = 7224;
constexpr int PN = 3328;
constexpr float ALPHA = 1.4142135623730951f;
constexpr float LN_EPS = 1e-5f;
constexpr int C_RQ = 0, C_RK = 128, C_RV = 256, C_RG = 512, C_DQ = 768, C_DK = 1024, C_DV = 1088, C_IQ = 1152, C_IK = 1408,
              C_NQ = 1440, C_NKC = 1696, C_NVC = 1760, C_NKS = 1824, C_NVS = 1888, C_NKW = 1952, C_NVW = 2016,
              C_SZ = 2080, C_SX = 2336, C_SB = 2592, C_SC = 2848, C_IW = 3104, C_NG = 3112, C_SDT = 3124;

constexpr int NTHREADS = 512, NWAVES = 8;
constexpr int LDS_BYTES = 152 * 1024;

constexpr size_t MiB = 1024 * 1024;
constexpr size_t WS_XF = 0;
constexpr size_t WS_XB = 64 * MiB;
constexpr size_t WS_YS = 96 * MiB;
constexpr size_t WS_BIG = 128 * MiB;
constexpr size_t WS_SLOTF = 232 * MiB;
constexpr size_t WS_WMIX = WS_SLOTF + 16 * MiB + 512 * 1024;
constexpr size_t WS_SMALL = WS_WMIX + 27 * MiB + 512 * 1024;
constexpr size_t WS_END = WS_SMALL + 8 * MiB;
constexpr size_t BIG_H = WS_BIG, BIG_PROJ = WS_BIG, BIG_GBUF = WS_BIG, BIG_MERGED = WS_BIG + 32 * MiB, BIG_QX = WS_BIG, BIG_AO = WS_BIG + 32 * MiB;
constexpr size_t W_GU = WS_SLOTF, W_DOWN = WS_SLOTF + 11 * MiB;
constexpr size_t W_IN = WS_WMIX, W_G = W_IN + (size_t)PN * 1024 * 2, W_B = W_G + 8 * MiB, W_OUT = W_B + 2 * MiB, W_Q = W_OUT + 2 * MiB,
                 W_KV = W_Q + 2 * MiB, W_O = W_KV + 4 * MiB, W_C1 = W_O + 2 * MiB, W_C2 = W_C1 + 512 * 1024, W_MIX_END = W_C2 + 16 * 1024;
static_assert(W_MIX_END <= WS_SMALL, "wmix overflow");
constexpr size_t S_MEMB = WS_SMALL, S_KVX = S_MEMB + 2 * MiB, S_TAB = S_KVX + 4 * MiB;

enum { IN_X = 0, IN_MEM, IN_LNG, IN_LNB, IN_F1GU, IN_F1DN, IN_WIN, IN_C1, IN_C2, IN_CPOS, IN_CONVW, IN_CONVB, IN_DTB, IN_ALOG, IN_DSKIP, IN_SNG,
       IN_WBR, IN_WOUT, IN_XQ, IN_XKV, IN_XO, IN_F2GU, IN_F2DN };

struct Params {
    const float* in[23];
    float* out;
    unsigned char* ws;
    int phase_lo, phase_hi;
};

DI float bf2f(bf16_t b) { return __uint_as_float(((unsigned)b) << 16); }
DI bf16_t f2bf(float f) { unsigned u = __float_as_uint(f); u += 0x7fffu + ((u >> 16) & 1u); return (bf16_t)(u >> 16); }
DI unsigned pk2(float lo, float hi) { unsigned r; asm volatile("v_cvt_pk_bf16_f32 %0, %1, %2" : "=v"(r) : "v"(lo), "v"(hi)); return r; }
DI float wave_sum(float v) {
#pragma unroll
    for (int o = 1; o < 64; o <<= 1) v += __shfl_xor(v, o);
    return v;
}
DI int launder(int t) { asm volatile("" : "+v"(t)); return t; }
DI int otid() { int t = threadIdx.x; asm volatile("" : "+v"(t)); return t; }
DI float sigmoidf_(float x) { return 1.0f / (1.0f + __expf(-x)); }
DI float siluf_(float x) { return x / (1.0f + __expf(-x)); }


#define XB_TMO      128
#define XB_XCNT(j)  (256  + 64 * (j))
#define XB_XSUB(j)  (1280 + 64 * (j))
#define XB_XGEN(j)  (2304 + 64 * (j))
#define XB_TOP      3328
#define XB_TOPGEN   3392
#define XCD_BAR_WORDS 3456
#define XB_SPIN_CAP (1u << 18)
DI unsigned xb_ld(unsigned* p) { return __hip_atomic_load(p, __ATOMIC_RELAXED, __HIP_MEMORY_SCOPE_AGENT); }
DI unsigned xb_add(unsigned* p, unsigned v) { return __hip_atomic_fetch_add(p, v, __ATOMIC_RELAXED, __HIP_MEMORY_SCOPE_AGENT); }
DI unsigned xb_xcc_id() { return (unsigned)__builtin_amdgcn_s_getreg((3 << 11) | 20) & 0xFu; }
#define XB_SPIN(cond, bar) do { unsigned _sp = 0; while (cond) { __builtin_amdgcn_s_sleep(1); \
    if ((++_sp & 255u) == 0u) { if (xb_ld(&(bar)[XB_TMO])) break; if (_sp > XB_SPIN_CAP) { atomicAdd(&(bar)[XB_TMO], 1u); break; } } } } while (0)
struct XcdBarrier { unsigned* bar; unsigned x; volatile LAS unsigned* st; };
DI XcdBarrier xcd_barrier_post(unsigned* bar, volatile LAS unsigned* st) {
    XcdBarrier b; b.bar = bar; b.x = xb_xcc_id(); b.st = st;
    if (threadIdx.x == 0) (void)xb_add(&bar[XB_XCNT(b.x)], 1u);
    return b;
}
DI void xcd_barrier_complete(unsigned* bar, unsigned x, unsigned& nloc, unsigned& nx) {
    const unsigned G = gridDim.x * gridDim.y * gridDim.z;
    unsigned sum, cnt, mine, sp = 0u;
    for (;;) {
        sum = 0u; cnt = 0u; mine = 0u;
#pragma unroll
        for (unsigned j = 0; j < 16; ++j) { const unsigned c = xb_ld(&bar[XB_XCNT(j)]); sum += c; cnt += (c > 0u) ? 1u : 0u; mine = (j == x) ? c : mine; }
        if (sum == G) break;
        __builtin_amdgcn_s_sleep(1);
        if ((++sp & 255u) == 0u) { if (xb_ld(&bar[XB_TMO])) break; if (sp > XB_SPIN_CAP) { atomicAdd(&bar[XB_TMO], 1u); break; } }
    }
    nloc = mine > 0u ? mine : 1u; nx = cnt > 0u ? cnt : 1u;
}
DI void xcd_barrier(const XcdBarrier& b) {
    asm volatile("s_waitcnt vmcnt(0)" ::: "memory");
    __syncthreads();
    if (threadIdx.x == 0) {
        unsigned* bar = b.bar;
        __builtin_amdgcn_s_waitcnt(0);
        unsigned nloc = b.st[0], nx = b.st[1];
        if (nloc == 0u) { xcd_barrier_complete(bar, b.x, nloc, nx); b.st[0] = nloc; b.st[1] = nx; }
        const unsigned old = xb_add(&bar[XB_XSUB(b.x)], 1u);
        const unsigned gen = old / nloc;
        if (old + 1u == (gen + 1u) * nloc) {
            __builtin_amdgcn_fence(__ATOMIC_RELEASE, "agent");
            asm volatile("s_waitcnt vmcnt(0)" ::: "memory");
            const unsigned og = xb_add(&bar[XB_TOP], 1u);
            const unsigned tg = og / nx;
            if (og + 1u == (tg + 1u) * nx) xb_add(&bar[XB_TOPGEN], 1u);
            else XB_SPIN(xb_ld(&bar[XB_TOPGEN]) == tg, bar);
            __builtin_amdgcn_fence(__ATOMIC_ACQUIRE, "agent");
            xb_add(&bar[XB_XGEN(b.x)], 1u);
            asm volatile("s_waitcnt vmcnt(0)" ::: "memory");
        } else {
            XB_SPIN(xb_ld(&bar[XB_XGEN(b.x)]) == gen, bar);
            __builtin_amdgcn_fence(__ATOMIC_ACQUIRE, "agent");
            asm volatile("s_waitcnt vmcnt(0)" ::: "memory");
        }
    }
    __syncthreads();
}
constexpr int L_XBST = 154432;

namespace pg8 {
constexpr int BM = 256, BK = 64, HALF = 128, HTB = HALF * BK * 2, STAGE_BYTES = 8 * HTB, NXCD = 8, WGM = 8;
DI int lds_byte(int r, int c) { const int st = (r >> 4) * 2 + (c >> 5), rr = r & 15, cc = c & 31, ob = rr * 64 + cc * 2; return st * 1024 + (ob ^ (((ob >> 9) & 1) << 5)); }
DI void stage_rc(int b, int& R, int& C) { const int st = b / 1024, sb = b % 1024, swz = sb ^ (((sb >> 9) & 1) << 5); R = (st >> 1) * 16 + swz / 64; C = (st & 1) * 32 + (swz % 64) / 2; }
DI int perm32(int rho) { const int n = rho >> 4, i = rho & 15; return 8 * (i >> 2) + 4 * n + (i & 3); }

struct Unit { int pm, pn; long aoff, boff; int nt, aux; };
struct Gemm { const bf16_t* A; const bf16_t* Bt; int lda, ldb; };

struct TileOrder {
    int nM, nN, nwg, G, c, nt;
    DI void init(int M, int N, int K, int G_, int c_) { nM = M / BM; nN = N / BM; nwg = nM * nN; G = G_; c = c_; nt = K / BK; }
    DI bool next(int i, Unit& u) const {
        const long L = (long)i * G + c; if (L >= nwg) return false;
        int wgid = (int)L; { const int q = nwg / NXCD, r = nwg % NXCD, xcd = wgid % NXCD, off = wgid / NXCD; wgid = (xcd < r ? xcd * (q + 1) : r * (q + 1) + (xcd - r) * q) + off; }
        const int nig = WGM * nN, gid = wgid / nig, fm = gid * WGM, gsz = (nM - fm) < WGM ? (nM - fm) : WGM;
        u.pm = fm + ((wgid % nig) % gsz); u.pn = (wgid % nig) / gsz; u.aoff = 0; u.boff = 0; u.nt = nt; u.aux = 0; return true;
    }
};

template <class Epi, class Sched>
DI void gemm_phase(LAS unsigned char* lds, const Gemm g, const Sched& S, const Epi& E) {
    const int tid = threadIdx.x, wid = __builtin_amdgcn_readfirstlane(tid >> 6), lane = tid & 63, wr = wid >> 2, wc = wid & 3, fr = lane & 15, fq = lane >> 4;
    unsigned voffA[2], voffB[2];
#pragma unroll
    for (int i = 0; i < 2; ++i) { int R, C; stage_rc(tid * 16 + i * 8192, R, C); const int Rb = Epi::PERM ? ((R & ~31) + perm32(R & 31)) : R;
        voffA[i] = (unsigned)(R * g.lda + C) * 2u; voffB[i] = (unsigned)(Rb * g.ldb + C) * 2u; }
    const size_t kstep = (size_t)(BK * 2);
    const size_t hstepA = (size_t)HALF * g.lda * 2, hstepB = (size_t)HALF * g.ldb * 2;
    const size_t tstepA = 2 * hstepA, tstepB = 2 * hstepB;
    const unsigned ldsw = (unsigned)wid * 1024u;
    const int aoff = lds_byte(wr * 64 + fr, fq * 8), boff = lds_byte(wc * 32 + fr, fq * 8);
#define PG8_SA(b, h) (((b) * 2 + (h)) * HTB)
#define PG8_SB(b, h) ((4 + (b) * 2 + (h)) * HTB)
#define PG8_STAGE(bufoff, gbase, voff) do { _Pragma("unroll") for (int _i = 0; _i < 2; ++_i) \
        __builtin_amdgcn_global_load_lds((const unsigned*)((const char*)(gbase) + (voff)[_i]), (LAS unsigned*)(lds + (bufoff) + ldsw + _i * 8192), 16, 0, 0); } while (0)
#define PG8_LDA(dst, b, h) do { _Pragma("unroll") for (int m = 0; m < 4; ++m) _Pragma("unroll") for (int k = 0; k < 2; ++k) dst[m][k] = *(const LAS bf16x8*)(lds + PG8_SA(b, h) + aoff + m * 2048 + k * 1024); } while (0)
#define PG8_LDB(dst, b, h) do { _Pragma("unroll") for (int n = 0; n < 2; ++n) _Pragma("unroll") for (int k = 0; k < 2; ++k) dst[n][k] = *(const LAS bf16x8*)(lds + PG8_SB(b, h) + boff + n * 2048 + k * 1024); } while (0)
#define PG8_MMA(ai, bj, At, Bt) do { __builtin_amdgcn_s_setprio(1); _Pragma("unroll") for (int m = 0; m < 4; ++m) _Pragma("unroll") for (int n = 0; n < 2; ++n) _Pragma("unroll") for (int k = 0; k < 2; ++k) \
        acc[ai][bj][m][n] = __builtin_amdgcn_mfma_f32_16x16x32_bf16(Bt[n][k], At[m][k], acc[ai][bj][m][n], 0, 0, 0); __builtin_amdgcn_s_setprio(0); } while (0)
#define PG8_WAIT_V(n) asm volatile("s_waitcnt vmcnt(" #n ")" ::: "memory")
#define PG8_WAIT_L(n) asm volatile("s_waitcnt lgkmcnt(" #n ")" ::: "memory")
#define PG8_BAR __builtin_amdgcn_s_barrier()
#define PG8_SCHED __builtin_amdgcn_sched_barrier(0)
    Unit cur, nxt; int ui = 0;
    if (!S.next(0, cur)) return;
    f32x4 acc[2][2][4][2];
#pragma unroll
    for (int a = 0; a < 2; ++a)
#pragma unroll
        for (int b = 0; b < 2; ++b)
#pragma unroll
            for (int m = 0; m < 4; ++m)
#pragma unroll
                for (int n = 0; n < 2; ++n) acc[a][b][m][n] = (f32x4){0.f, 0.f, 0.f, 0.f};
    bf16x8 At[4][2], B0[2][2], B1[2][2];
    const char* cA = (const char*)g.A + (size_t)cur.pm * tstepA + cur.aoff; const char* cB = (const char*)g.Bt + (size_t)cur.pn * tstepB + cur.boff;
    PG8_STAGE(PG8_SB(0, 0), cB, voffB); PG8_STAGE(PG8_SA(0, 0), cA, voffA); PG8_STAGE(PG8_SB(0, 1), cB + hstepB, voffB); PG8_STAGE(PG8_SA(0, 1), cA + hstepA, voffA);
    if (wr == 1) PG8_BAR;
    PG8_WAIT_V(4); PG8_BAR;
    PG8_STAGE(PG8_SB(1, 0), cB + kstep, voffB); PG8_STAGE(PG8_SA(1, 0), cA + kstep, voffA); PG8_STAGE(PG8_SB(1, 1), cB + hstepB + kstep, voffB);
    PG8_WAIT_V(6); PG8_BAR;
    for (;;) {
        const bool has_next = S.next(ui + 1, nxt);
        const char* nA = has_next ? (const char*)g.A + (size_t)nxt.pm * tstepA + nxt.aoff : cA; const char* nB = has_next ? (const char*)g.Bt + (size_t)nxt.pn * tstepB + nxt.boff : cB;
        const int nt = cur.nt;
        for (int t = 0; t < nt; t += 2) {
            const bool last = (t == nt - 2);
            const char* a1 = cA + (size_t)(t + 1) * kstep;
            const char* a2 = last ? nA : cA + (size_t)(t + 2) * kstep; const char* b2 = last ? nB : cB + (size_t)(t + 2) * kstep;
            const char* a3 = a2 + kstep; const char* b3 = b2 + kstep;
            PG8_LDB(B0, 0, 0); PG8_SCHED; PG8_LDA(At, 0, 0); PG8_STAGE(PG8_SA(1, 1), a1 + hstepA, voffA);
            PG8_WAIT_L(8); PG8_BAR; PG8_WAIT_L(0); PG8_MMA(0, 0, At, B0); PG8_BAR; PG8_SCHED;
            PG8_LDB(B1, 0, 1); PG8_STAGE(PG8_SB(0, 0), b2, voffB);
            PG8_BAR; PG8_WAIT_L(0); PG8_MMA(0, 1, At, B1); PG8_BAR;
            PG8_LDA(At, 0, 1); PG8_STAGE(PG8_SA(0, 0), a2, voffA);
            PG8_BAR; PG8_WAIT_L(0); PG8_MMA(1, 0, At, B0); PG8_BAR; PG8_SCHED;
            PG8_STAGE(PG8_SB(0, 1), b2 + hstepB, voffB);
            PG8_WAIT_V(6); PG8_BAR; PG8_MMA(1, 1, At, B1); PG8_BAR;
            PG8_LDB(B0, 1, 0); PG8_SCHED; PG8_LDA(At, 1, 0); PG8_STAGE(PG8_SA(0, 1), a2 + hstepA, voffA);
            PG8_WAIT_L(8); PG8_BAR; PG8_WAIT_L(0); PG8_MMA(0, 0, At, B0); PG8_BAR; PG8_SCHED;
            PG8_LDB(B1, 1, 1); PG8_STAGE(PG8_SB(1, 0), b3, voffB);
            PG8_BAR; PG8_WAIT_L(0); PG8_MMA(0, 1, At, B1); PG8_BAR;
            PG8_LDA(At, 1, 1); PG8_STAGE(PG8_SA(1, 0), a3, voffA);
            PG8_BAR; PG8_WAIT_L(0); PG8_MMA(1, 0, At, B0); PG8_BAR; PG8_SCHED;
            PG8_STAGE(PG8_SB(1, 1), b3 + hstepB, voffB);
            PG8_WAIT_V(6); PG8_BAR; PG8_MMA(1, 1, At, B1); PG8_BAR;
        }
        E(acc, cur, wr, wc, fr, fq);
        if (!has_next) break;
#pragma unroll
        for (int a = 0; a < 2; ++a)
#pragma unroll
            for (int b = 0; b < 2; ++b)
#pragma unroll
                for (int m = 0; m < 4; ++m)
#pragma unroll
                    for (int n = 0; n < 2; ++n) acc[a][b][m][n] = (f32x4){0.f, 0.f, 0.f, 0.f};
        cur = nxt; cA = nA; cB = nB; ++ui;
    }
    PG8_WAIT_V(0);
    if (wr == 0) PG8_BAR;
    PG8_BAR;
#undef PG8_SA
#undef PG8_SB
#undef PG8_STAGE
#undef PG8_LDA
#undef PG8_LDB
#undef PG8_MMA
#undef PG8_WAIT_V
#undef PG8_WAIT_L
#undef PG8_BAR
#undef PG8_SCHED
}

struct EpiSwiGLU {
    static constexpr bool PERM = false;
    bf16_t* H;
    DI void operator()(const f32x4 (&acc)[2][2][4][2], const Unit& u, int wr, int wc, int fr, int fq) const {
        const int row0 = u.pm * BM + wr * 64 + fr, hc0 = u.pn * 128 + wc * 16 + fq * 4;
#pragma unroll
        for (int ai = 0; ai < 2; ++ai)
#pragma unroll
            for (int m = 0; m < 4; ++m) { bf16_t* rowp = H + (size_t)(row0 + ai * HALF + m * 16) * DFF + hc0;
#pragma unroll
                for (int bj = 0; bj < 2; ++bj) { const f32x4 gg = acc[ai][bj][m][0], uu = acc[ai][bj][m][1];
                    u32x2 w; w.x = pk2(siluf_(gg[0]) * uu[0], siluf_(gg[1]) * uu[1]); w.y = pk2(siluf_(gg[2]) * uu[2], siluf_(gg[3]) * uu[3]);
                    *(u32x2*)(rowp + bj * 64) = w; } }
    }
};
struct EpiResid {
    static constexpr bool PERM = false;
    float* X; float s;
    DI void operator()(const f32x4 (&acc)[2][2][4][2], const Unit& u, int wr, int wc, int fr, int fq) const {
        const int row0 = u.pm * BM + wr * 64 + fr, col0 = u.pn * BM + wc * 32 + 4 * fq;
#pragma unroll
        for (int ai = 0; ai < 2; ++ai)
#pragma unroll
            for (int m = 0; m < 4; ++m) { float* rowp = X + (size_t)(row0 + ai * HALF + m * 16) * DM + col0;
#pragma unroll
                for (int bj = 0; bj < 2; ++bj)
#pragma unroll
                    for (int n = 0; n < 2; ++n) { f32x4* p = (f32x4*)(rowp + bj * HALF + n * 16); const f32x4 o = *p; *p = o * ALPHA + acc[ai][bj][m][n] * s; } }
    }
};
struct EpiBf16 {
    static constexpr bool PERM = true;
    bf16_t* O; int ldc;
    DI void operator()(const f32x4 (&acc)[2][2][4][2], const Unit& u, int wr, int wc, int fr, int fq) const {
        const int row0 = u.pm * BM + wr * 64 + fr, col0 = u.pn * BM + wc * 32 + 8 * fq;
#pragma unroll
        for (int ai = 0; ai < 2; ++ai)
#pragma unroll
            for (int m = 0; m < 4; ++m) { bf16_t* rowp = O + (size_t)(row0 + ai * HALF + m * 16) * ldc + col0;
#pragma unroll
                for (int bj = 0; bj < 2; ++bj) { const f32x4 v0 = acc[ai][bj][m][0], v1 = acc[ai][bj][m][1];
                    u32x4 w; w.x = pk2(v0[0], v0[1]); w.y = pk2(v0[2], v0[3]); w.z = pk2(v1[0], v1[1]); w.w = pk2(v1[2], v1[3]);
                    *(u32x4*)(rowp + bj * HALF) = w; } }
    }
};
}

enum { MAP_ID = 0, MAP_GU = 1, MAP_IN = 2, MAP_GATE = 3 };
DI int map_col(int kind, int r) {
    if (kind == MAP_GU) { const int pn = r >> 8, c = r & 255; const int bj = c >> 7, wc = (c >> 5) & 3, n = (c >> 4) & 1, fq = (c >> 2) & 3, j = c & 3; return n * DFF + pn * 128 + bj * 64 + wc * 16 + fq * 4 + j; }
    if (kind == MAP_IN) {
        if (r < 1440) return r;
        if (r < 2080) return r + 8;
        if (r < 3104) return r + 20;
        if (r < 3112) return r - 3104 + 1440;
        if (r < 3124) return r - 3112 + 2088;
        if (r < 3128) return r;
        return -1;
    }
    if (kind == MAP_GATE) return 3128 + r;
    return r;
}
DI void cvt_item(const float* W, int K, int N, bf16_t* WT, int kind, LAS float* scr, int item, int nblk, int lane) {
    const int kb = item / nblk, nb = item % nblk, k0 = 64 * kb, n0 = 32 * nb;
    const int sc = map_col(kind, n0 + (lane & 31));
#pragma unroll 8
    for (int i = 0; i < 32; ++i) { const int kk = 2 * i + (lane >> 5); scr[kk * 33 + (lane & 31)] = sc >= 0 ? W[(size_t)(k0 + kk) * N + sc] : 0.f; }
    asm volatile("s_waitcnt lgkmcnt(0)" ::: "memory");
    const int c = lane & 7;
#pragma unroll
    for (int j = 0; j < 4; ++j) { const int n = (lane >> 3) + 8 * j; const LAS float* s = scr + (8 * c) * 33 + n;
        u32x4 o; o.x = pk2(s[0 * 33], s[1 * 33]); o.y = pk2(s[2 * 33], s[3 * 33]); o.z = pk2(s[4 * 33], s[5 * 33]); o.w = pk2(s[6 * 33], s[7 * 33]);
        *(u32x4*)(WT + (size_t)(n0 + n) * K + k0 + 8 * c) = o; }
    asm volatile("s_waitcnt lgkmcnt(0)" ::: "memory");
}
DI void cvt_matrix(const float* W, int K, int N, bf16_t* WT, int rows, int kind, LAS unsigned char* lds, int c, int G) {
    const int tid = otid(), wave = tid >> 6, gw = c * NWAVES + wave, ngw = G * NWAVES;
    LAS float* scr = (LAS float*)(lds + wave * 16384);
    const int nblk = rows / 32, nitems = (K / 64) * nblk, lane = tid & 63;
    for (int it = gw; it < nitems; it += ngw) cvt_item(W, K, N, WT, kind, scr, it, nblk, lane);
}

DI void ln_phase(float* X, bf16_t* XB, float* OUT, const float* g, const float* b, int c, int G) {
    const int tid = otid(), lane = tid & 63, gw = c * NWAVES + (tid >> 6), ngw = G * NWAVES;
    f32x4 gv[4], bv[4];
#pragma unroll
    for (int j = 0; j < 4; ++j) { gv[j] = ((const f32x4*)g)[lane + 64 * j]; bv[j] = ((const f32x4*)b)[lane + 64 * j]; }
    for (int row = gw; row < NTOK; row += ngw) {
        f32x4* xr = (f32x4*)(X + (size_t)row * DM) + lane;
        f32x4 v[4]; float s = 0.f;
#pragma unroll
        for (int j = 0; j < 4; ++j) { v[j] = xr[64 * j]; s += (v[j][0] + v[j][1]) + (v[j][2] + v[j][3]); }
        const float mean = wave_sum(s) * (1.f / DM); float s2 = 0.f;
#pragma unroll
        for (int j = 0; j < 4; ++j) { v[j] = v[j] - mean; s2 += (v[j][0] * v[j][0] + v[j][1] * v[j][1]) + (v[j][2] * v[j][2] + v[j][3] * v[j][3]); }
        const float rstd = 1.0f / sqrtf(wave_sum(s2) * (1.f / DM) + LN_EPS);
        float* orow = OUT ? OUT + (size_t)row * DM : X + (size_t)row * DM;
#pragma unroll
        for (int j = 0; j < 4; ++j) { const f32x4 o = v[j] * rstd * gv[j] + bv[j]; ((f32x4*)orow)[lane + 64 * j] = o;
            if (XB) { u32x2 w; w.x = pk2(o[0], o[1]); w.y = pk2(o[2], o[3]); ((u32x2*)(XB + (size_t)row * DM))[lane + 64 * j] = w; } }
    }
}


struct EpiKV {
    static constexpr bool PERM = true;
    bf16_t* KX; bf16_t* VT;
    DI void operator()(const f32x4 (&acc)[2][2][4][2], const pg8::Unit& u, int wr, int wc, int fr, int fq) const {
        const int row0 = wr * 64 + fr, col0 = u.pn * 256 + wc * 32 + 8 * fq;
#pragma unroll
        for (int ai = 0; ai < 2; ++ai)
#pragma unroll
            for (int m = 0; m < 4; ++m) { const int mr = row0 + ai * 128 + m * 16;
#pragma unroll
                for (int bj = 0; bj < 2; ++bj) { const f32x4 v0 = acc[ai][bj][m][0], v1 = acc[ai][bj][m][1]; const int col = col0 + bj * 128;
                    if (u.pn < 4) { u32x4 w; w.x = pk2(v0[0], v0[1]); w.y = pk2(v0[2], v0[3]); w.z = pk2(v1[0], v1[1]); w.w = pk2(v1[2], v1[3]);
                        *(u32x4*)(KX + (size_t)(u.pm * 256 + mr) * DM + col) = w; }
                    else { bf16_t* vp = VT + ((size_t)u.pm * DM + (col - DM)) * NMEM + mr;
#pragma unroll
                        for (int e = 0; e < 4; ++e) { vp[(size_t)e * NMEM] = f2bf(v0[e]); vp[(size_t)(e + 4) * NMEM] = f2bf(v1[e]); } } } }
    }
};
#define MFMA32(a, b, c) __builtin_amdgcn_mfma_f32_32x32x16_bf16((a), (b), (c), 0, 0, 0)
DI float half_max(float v) {
#pragma unroll
    for (int o = 1; o < 32; o <<= 1) v = fmaxf(v, __shfl_xor(v, o));
    return v;
}
DI float half_sum(float v) {
#pragma unroll
    for (int o = 1; o < 32; o <<= 1) v += __shfl_xor(v, o);
    return v;
}
DI int crow(int r, int hh) { return 8 * (r >> 2) + 4 * hh + (r & 3); }
DI void xattn_phase(const bf16_t* qx, const bf16_t* kx, const bf16_t* vT, bf16_t* ao, LAS unsigned char* lds, int c, int G) {
    const int tid = otid(), lane = tid & 63, wave = tid >> 6, r32 = lane & 31, hh = lane >> 5;
    LAS bf16_t* P = (LAS bf16_t*)(lds + wave * (32 * 264 * 2));
    for (int item = c * NWAVES + wave; item < 2048; item += G * NWAVES) {
        const int b = item >> 9, h = (item >> 7) & 3, t0 = (item & 127) * 32;
        const bf16_t* qrow = qx + (size_t)(b * SEQ + t0 + r32) * DM + h * 256 + hh * 8;
        const bf16_t* krow = kx + (size_t)(b * NMEM + r32) * DM + h * 256 + hh * 8;
        f32x16 S[8];
#pragma unroll
        for (int j = 0; j < 8; ++j)
#pragma unroll
            for (int r = 0; r < 16; ++r) S[j][r] = 0.f;
#pragma unroll 2
        for (int ks = 0; ks < 16; ++ks) {
            const bf16x8 a = *(const bf16x8*)(qrow + ks * 16);
#pragma unroll
            for (int j = 0; j < 8; ++j) { const bf16x8 bb = *(const bf16x8*)(krow + (size_t)j * 32 * DM + ks * 16); S[j] = MFMA32(a, bb, S[j]); }
        }
        float inv[16];
#pragma unroll
        for (int r = 0; r < 16; ++r) {
            float m = S[0][r];
#pragma unroll
            for (int j = 1; j < 8; ++j) m = fmaxf(m, S[j][r]);
            m = half_max(m);
            float sm = 0.f;
#pragma unroll
            for (int j = 0; j < 8; ++j) { const float e = __expf((S[j][r] - m) * 0.0625f); sm += e; P[crow(r, hh) * 264 + j * 32 + r32] = f2bf(e); }
            inv[r] = 1.0f / half_sum(sm);
        }
        const bf16_t* vrow = vT + ((size_t)b * DM + h * 256 + r32) * NMEM + hh * 8;
        bf16_t* orow = ao + (size_t)(b * SEQ + t0) * DM + h * 256 + r32;
#pragma unroll 1
        for (int half = 0; half < 2; ++half) {
            f32x16 O[4];
#pragma unroll
            for (int j = 0; j < 4; ++j)
#pragma unroll
                for (int r = 0; r < 16; ++r) O[j][r] = 0.f;
#pragma unroll 2
            for (int ks = 0; ks < 16; ++ks) {
                const bf16x8 a = *(const LAS bf16x8*)(P + r32 * 264 + ks * 16 + hh * 8);
#pragma unroll
                for (int j = 0; j < 4; ++j) { const bf16x8 bb = *(const bf16x8*)(vrow + (size_t)(half * 4 + j) * 32 * NMEM + ks * 16); O[j] = MFMA32(a, bb, O[j]); }
            }
#pragma unroll
            for (int r = 0; r < 16; ++r)
#pragma unroll
                for (int j = 0; j < 4; ++j) orow[(size_t)crow(r, hh) * DM + (half * 4 + j) * 32] = f2bf(O[j][r] * inv[r]);
        }
    }
}

constexpr size_t X_DVT = WS_SLOTF, X_NVST = X_DVT + 2 * MiB, X_NVWT = X_NVST + 2 * MiB;
constexpr size_t X_RST = X_NVWT + 2 * MiB;
constexpr size_t X_SST = X_RST + 2 * MiB;
constexpr size_t X_CDEC = X_SST + 8 * MiB;
constexpr size_t X_END = X_CDEC + 4096;
static_assert(X_END <= WS_WMIX, "mixer scratch overflow");
constexpr size_t S_KCMP = S_TAB + 1 * MiB, S_VCMPT = S_KCMP + 128 * 1024, S_BAR = S_VCMPT + 128 * 1024;
constexpr size_t T_RC = S_TAB, T_RS = T_RC + 4096 * 16 * 4, T_AC = T_RS + 4096 * 16 * 4, T_AS = T_AC + 4096 * 8 * 4, T_IC = T_AS + 4096 * 8 * 4, T_IS = T_IC + 4096 * 4 * 4;
static_assert(T_IS + 4096 * 4 * 4 <= S_KCMP && S_BAR + 16384 <= WS_END, "small overflow");

DI void table_phase(unsigned char* ws, int c, int G) {
    const int tid = otid();
    for (int i = c * NTHREADS + tid; i < 4096 * 28; i += G * NTHREADS) {
        const int pos = i / 28, k = i % 28; double theta; int idx, rot; float *cp, *sp;
        if (k < 16) { theta = 10000.0; idx = k; rot = 32; cp = (float*)(ws + T_RC) + pos * 16 + idx; sp = (float*)(ws + T_RS) + pos * 16 + idx; }
        else if (k < 24) { theta = 500000.0; idx = k - 16; rot = 16; cp = (float*)(ws + T_AC) + pos * 8 + idx; sp = (float*)(ws + T_AS) + pos * 8 + idx; }
        else { theta = 500000.0; idx = k - 24; rot = 8; cp = (float*)(ws + T_IC) + pos * 4 + idx; sp = (float*)(ws + T_IS) + pos * 4 + idx; }
        const float inv = (float)exp2(-2.0 * idx / rot * log2(theta));
        const float ang = (float)pos * inv;
        double rev = (double)ang * 0.15915494309189533577; rev -= rint(rev);
        const float rf = (float)rev;
        *cp = __builtin_amdgcn_cosf(rf); *sp = __builtin_amdgcn_sinf(rf);
    }
}

DI void rope_pair(bf16_t* row, int c1, int c2, float cs, float sn, float scale) {
    const float x1 = bf2f(row[c1]), x2 = bf2f(row[c2]);
    row[c1] = f2bf((x1 * cs - x2 * sn) * scale); row[c2] = f2bf((x2 * cs + x1 * sn) * scale);
}
DI void prep_phase(unsigned char* ws, LAS unsigned char* lds, int c, int G) {
    const int tid = otid();
    bf16_t* proj = (bf16_t*)(ws + BIG_PROJ);
    const float *trc = (const float*)(ws + T_RC), *trs = (const float*)(ws + T_RS), *tac = (const float*)(ws + T_AC), *tas = (const float*)(ws + T_AS), *tic = (const float*)(ws + T_IC), *tis = (const float*)(ws + T_IS);
    LAS bf16_t* tile = (LAS bf16_t*)lds;
    for (int it = c; it < NTOK / 64; it += G) {
        const int tok0 = it * 64, b = tok0 / SEQ, p0 = tok0 % SEQ;
        for (int idx = tid; idx < 64 * 260; idx += NTHREADS) {
            const int tl = idx / 260, pr = idx % 260, pos = p0 + tl; bf16_t* row = proj + (size_t)(tok0 + tl) * PN;
            if (pr < 128) { const int q = pr & 63, hd = q >> 4, i = q & 15, base = (pr < 64 ? C_RQ : C_RK) + hd * 32 + i; rope_pair(row, base, base + 16, trc[pos * 16 + i], trs[pos * 16 + i], pr < 64 ? 1.0f : 0.17677669529663687f); }
            else if (pr < 160) { const int q = pr - 128, hd = q >> 3, i = q & 7, base = C_DQ + hd * 64 + i; rope_pair(row, base, base + 8, tac[pos * 8 + i], tas[pos * 8 + i], 1.0f); }
            else if (pr < 168) { const int i = pr - 160, base = C_DK + i; rope_pair(row, base, base + 8, tac[pos * 8 + i], tas[pos * 8 + i], 1.0f); }
            else if (pr < 200) { const int q = pr - 168, hd = q >> 2, i = q & 3, base = C_IQ + hd * 32 + i; rope_pair(row, base, base + 4, tic[pos * 4 + i], tis[pos * 4 + i], 1.0f); }
            else if (pr < 204) { const int i = pr - 200, base = C_IK + i; rope_pair(row, base, base + 4, tic[pos * 4 + i], tis[pos * 4 + i], 1.0f); }
            else if (pr < 236) { const int q = pr - 204, hd = q >> 3, i = q & 7, base = C_NQ + hd * 64 + i; rope_pair(row, base, base + 8, tac[pos * 8 + i], tas[pos * 8 + i], 1.0f); }
            else { const int q = pr - 236, w = q >> 3, i = q & 7, base = (w == 0 ? C_NKC : (w == 1 ? C_NKS : C_NKW)) + i; rope_pair(row, base, base + 8, tac[pos * 8 + i], tas[pos * 8 + i], 1.0f); }
        }
        for (int m = 0; m < 3; ++m) {
            const int col = m == 0 ? C_DV : (m == 1 ? C_NVS : C_NVW); bf16_t* vT = (bf16_t*)(ws + (m == 0 ? X_DVT : (m == 1 ? X_NVST : X_NVWT)));
            __syncthreads();
            { const int tl = tid >> 3, ch = tid & 7; const u32x4 v = *(const u32x4*)(proj + (size_t)(tok0 + tl) * PN + col + ch * 8);
              LAS unsigned* d = (LAS unsigned*)(tile + tl * 66 + ch * 8); d[0] = v.x; d[1] = v.y; d[2] = v.z; d[3] = v.w; }
            __syncthreads();
            { const int d = tid >> 3, tc = tid & 7; unsigned w[4];
#pragma unroll
              for (int k = 0; k < 4; ++k) w[k] = (unsigned)tile[(tc * 8 + 2 * k) * 66 + d] | ((unsigned)tile[(tc * 8 + 2 * k + 1) * 66 + d] << 16);
              u32x4 o; o.x = w[0]; o.y = w[1]; o.z = w[2]; o.w = w[3];
              *(u32x4*)(vT + ((size_t)b * 64 + d) * SEQ + p0 + tc * 8) = o; }
        }
        __syncthreads();
    }
}

DI float gelu_tanh(float x) { const float u = 0.7978845608028654f * (x + 0.044715f * x * x * x); const float t = 1.0f - 2.0f / (1.0f + __expf(2.0f * u)); return 0.5f * x * (1.0f + t); }
DI void compress_phase(const Params& p, int l, unsigned char* ws, LAS unsigned char* lds, int c, int G) {
    const int tid = otid(), lane = tid & 63, wave = tid >> 6, r32 = lane & 31, hh = lane >> 5;
    const bf16_t* proj = (const bf16_t*)(ws + BIG_PROJ);
    LAS float* part = (LAS float*)lds;
    LAS bf16_t* hbuf = (LAS bf16_t*)(lds + 65536);
    for (int it = c; it < 64; it += G) {
        const int which = it & 1, mt = (it >> 1) & 7, b = it >> 4;
        const float* cpos = p.in[IN_CPOS] + (size_t)(l * 2 + which) * 32 * 64;
        const bf16_t* w1t = (const bf16_t*)(ws + W_C1) + (size_t)which * 64 * 2048;
        const bf16_t* w2t = (const bf16_t*)(ws + W_C2) + (size_t)which * 64 * 64;
        int cb = mt * 32 + r32; if (cb > 254) cb = 254;
        const bf16_t* src = proj + (size_t)(b * SEQ + 16 * cb) * PN + (which ? C_NVC : C_NKC);
        f32x16 acc[2];
#pragma unroll
        for (int n = 0; n < 2; ++n)
#pragma unroll
            for (int r = 0; r < 16; ++r) acc[n][r] = 0.f;
        for (int ks = wave * 16; ks < wave * 16 + 16; ++ks) {
            const int k0 = ks * 16 + hh * 8, lt = k0 >> 6, d = k0 & 63;
            const u32x4 raw = *(const u32x4*)(src + (size_t)lt * PN + d);
            const f32x4 p0 = *(const f32x4*)(cpos + lt * 64 + d), p1 = *(const f32x4*)(cpos + lt * 64 + d + 4);
            u32x4 av; av.x = pk2(__uint_as_float(raw.x << 16) + p0[0], __uint_as_float(raw.x & 0xffff0000u) + p0[1]); av.y = pk2(__uint_as_float(raw.y << 16) + p0[2], __uint_as_float(raw.y & 0xffff0000u) + p0[3]);
            av.z = pk2(__uint_as_float(raw.z << 16) + p1[0], __uint_as_float(raw.z & 0xffff0000u) + p1[1]); av.w = pk2(__uint_as_float(raw.w << 16) + p1[2], __uint_as_float(raw.w & 0xffff0000u) + p1[3]);
            const bf16x8 a = __builtin_bit_cast(bf16x8, av);
#pragma unroll
            for (int n = 0; n < 2; ++n) { const bf16x8 bb = *(const bf16x8*)(w1t + (size_t)(n * 32 + r32) * 2048 + ks * 16 + hh * 8); acc[n] = MFMA32(a, bb, acc[n]); }
        }
        __syncthreads();
#pragma unroll
        for (int n = 0; n < 2; ++n)
#pragma unroll
            for (int r = 0; r < 16; ++r) part[(wave * 32 + crow(r, hh)) * 64 + n * 32 + r32] = acc[n][r];
        __syncthreads();
        for (int e = tid; e < 32 * 64; e += NTHREADS) { float sacc = 0.f;
#pragma unroll
            for (int w = 0; w < 8; ++w) sacc += part[w * 2048 + e];
            hbuf[(e >> 6) * 72 + (e & 63)] = f2bf(gelu_tanh(sacc)); }
        __syncthreads();
        if (wave == 0) {
            f32x16 o[2];
#pragma unroll
            for (int n = 0; n < 2; ++n)
#pragma unroll
                for (int r = 0; r < 16; ++r) o[n][r] = 0.f;
#pragma unroll
            for (int ks = 0; ks < 4; ++ks) { const bf16x8 a = *(const LAS bf16x8*)(hbuf + r32 * 72 + ks * 16 + hh * 8);
#pragma unroll
                for (int n = 0; n < 2; ++n) { const bf16x8 bb = *(const bf16x8*)(w2t + (size_t)(n * 32 + r32) * 64 + ks * 16 + hh * 8); o[n] = MFMA32(a, bb, o[n]); } }
#pragma unroll
            for (int n = 0; n < 2; ++n)
#pragma unroll
                for (int r = 0; r < 16; ++r) { const int cbi = mt * 32 + crow(r, hh), col = n * 32 + r32;
                    if (which == 0) ((bf16_t*)(ws + S_KCMP))[((size_t)b * 256 + cbi) * 64 + col] = f2bf(o[n][r]);
                    else ((bf16_t*)(ws + S_VCMPT))[((size_t)b * 64 + col) * 256 + cbi] = f2bf(o[n][r]); }
        }
        __syncthreads();
    }
}

DI float ret_lg(int h) { return log1pf(-exp2f(-5.0f - (float)h)); }
DI void ret_state_phase(unsigned char* ws, int c, int G) {
    const int tid = otid(), lane = tid & 63, wave = tid >> 6, r32 = lane & 31, hh = lane >> 5;
    const bf16_t* proj = (const bf16_t*)(ws + BIG_PROJ); bf16_t* rst = (bf16_t*)(ws + X_RST);
    for (int it = c * NWAVES + wave; it < NB * 32 * 4; it += G * NWAVES) {
        const int h = it & 3, n = (it >> 2) & 31, b = it >> 7; const float lg = ret_lg(h);
        const bf16_t* base = proj + (size_t)(b * SEQ + n * 128) * PN;
        f32x16 acc[2];
#pragma unroll
        for (int q = 0; q < 2; ++q)
#pragma unroll
            for (int r = 0; r < 16; ++r) acc[q][r] = 0.f;
        for (int ks = 0; ks < 8; ++ks) {
            bf16x8 a, b0, b1;
#pragma unroll
            for (int j = 0; j < 8; ++j) { const int tok = ks * 16 + hh * 8 + j; const bf16_t* row = base + (size_t)tok * PN;
                a[j] = (short)f2bf(bf2f(row[C_RK + h * 32 + r32]) * __expf((float)(127 - tok) * lg));
                b0[j] = (short)row[C_RV + h * 64 + r32]; b1[j] = (short)row[C_RV + h * 64 + 32 + r32]; }
            acc[0] = MFMA32(a, b0, acc[0]); acc[1] = MFMA32(a, b1, acc[1]);
        }
        bf16_t* dst = rst + (size_t)it * 64 * 32;
#pragma unroll
        for (int q = 0; q < 2; ++q)
#pragma unroll
            for (int r = 0; r < 16; ++r) dst[(q * 32 + r32) * 32 + crow(r, hh)] = f2bf(acc[q][r]);
    }
}
DI void ret_scan_phase(unsigned char* ws, int c, int G) {
    const int tid = otid(); bf16_t* rst = (bf16_t*)(ws + X_RST);
    for (int e = c * NTHREADS + tid; e < NB * 4 * 2048; e += G * NTHREADS) {
        const int el = e & 2047, h = (e >> 11) & 3, b = e >> 13; const float cd = __expf(128.0f * ret_lg(h));
        float st = 0.f;
        for (int n = 0; n < 32; ++n) { bf16_t* ptr = rst + ((size_t)((b * 32 + n) * 4 + h)) * 2048 + el; const float cin = bf2f(*ptr); *ptr = f2bf(st); st = st * cd + cin; }
    }
}
DI void ret_out_phase(unsigned char* ws, LAS unsigned char* lds, int c, int G) {
    const int tid = otid(), lane = tid & 63, wave = tid >> 6, r32 = lane & 31, hh = lane >> 5;
    const bf16_t* proj = (const bf16_t*)(ws + BIG_PROJ); const bf16_t* rst = (const bf16_t*)(ws + X_RST); bf16_t* ys = (bf16_t*)(ws + WS_YS);
    LAS bf16_t* Sb = (LAS bf16_t*)lds;
    LAS float* ob = (LAS float*)(lds + 128 * 136 * 2);
    for (int it = c; it < NB * 32 * 4; it += G) {
        const int h = it & 3, n = (it >> 2) & 31, b = it >> 7; const float lg = ret_lg(h);
        const bf16_t* base = proj + (size_t)(b * SEQ + n * 128) * PN;
        const int mi = wave >> 1;
        { f32x16 sacc[2];
#pragma unroll
          for (int q = 0; q < 2; ++q)
#pragma unroll
              for (int r = 0; r < 16; ++r) sacc[q][r] = 0.f;
#pragma unroll
          for (int ks = 0; ks < 2; ++ks) { const bf16x8 a = *(const bf16x8*)(base + (size_t)(mi * 32 + r32) * PN + C_RQ + h * 32 + ks * 16 + hh * 8);
#pragma unroll
              for (int q = 0; q < 2; ++q) { const int nj = (wave & 1) * 2 + q; const bf16x8 bb = *(const bf16x8*)(base + (size_t)(nj * 32 + r32) * PN + C_RK + h * 32 + ks * 16 + hh * 8); sacc[q] = MFMA32(a, bb, sacc[q]); } }
#pragma unroll
          for (int q = 0; q < 2; ++q) { const int j = ((wave & 1) * 2 + q) * 32 + r32;
#pragma unroll
              for (int r = 0; r < 16; ++r) { const int i = mi * 32 + crow(r, hh); const float dec = i >= j ? __expf((float)(i - j) * lg) : 0.f; Sb[i * 136 + j] = f2bf(sacc[q][r] * dec); } }
        }
        __syncthreads();
        { const int ni = wave & 1; f32x16 o;
#pragma unroll
          for (int r = 0; r < 16; ++r) o[r] = 0.f;
          for (int ks = 0; ks < 8; ++ks) { const bf16x8 a = *(const LAS bf16x8*)(Sb + (mi * 32 + r32) * 136 + ks * 16 + hh * 8); bf16x8 bb;
#pragma unroll
              for (int j = 0; j < 8; ++j) bb[j] = (short)base[(size_t)(ks * 16 + hh * 8 + j) * PN + C_RV + h * 64 + ni * 32 + r32];
              o = MFMA32(a, bb, o); }
          f32x16 cr;
#pragma unroll
          for (int r = 0; r < 16; ++r) cr[r] = 0.f;
          const bf16_t* prev = rst + (size_t)it * 2048;
#pragma unroll
          for (int ks = 0; ks < 2; ++ks) { const bf16x8 a = *(const bf16x8*)(base + (size_t)(mi * 32 + r32) * PN + C_RQ + h * 32 + ks * 16 + hh * 8);
              const bf16x8 bb = *(const bf16x8*)(prev + (ni * 32 + r32) * 32 + ks * 16 + hh * 8); cr = MFMA32(a, bb, cr); }
#pragma unroll
          for (int r = 0; r < 16; ++r) { const int i = mi * 32 + crow(r, hh); ob[i * 65 + ni * 32 + r32] = o[r] + cr[r] * __expf((float)(i + 1) * lg); }
        }
        __syncthreads();
        { const int i = tid >> 2, q4 = tid & 3; float v[16], sm = 0.f;
#pragma unroll
          for (int k = 0; k < 16; ++k) { v[k] = ob[i * 65 + q4 * 16 + k]; sm += v[k]; }
          sm += __shfl_xor(sm, 1); sm += __shfl_xor(sm, 2); const float mean = sm * (1.f / 64.f); float s2 = 0.f;
#pragma unroll
          for (int k = 0; k < 16; ++k) { v[k] -= mean; s2 += v[k] * v[k]; }
          s2 += __shfl_xor(s2, 1); s2 += __shfl_xor(s2, 2); const float rstd = 1.0f / sqrtf(s2 * (1.f / 64.f) + LN_EPS);
          const bf16_t* grow = base + (size_t)i * PN + C_RG + h * 64 + q4 * 16; bf16_t* yrow = ys + (size_t)(b * SEQ + n * 128 + i) * DM + h * 64 + q4 * 16;
#pragma unroll
          for (int k = 0; k < 16; ++k) yrow[k] = f2bf(siluf_(bf2f(grow[k])) * (v[k] * rstd)); }
        __syncthreads();
    }
}

DI float softplusf_(float x) { return x > 20.f ? x : log1pf(__expf(x)); }
DI float conv_silu(const bf16_t* projb, int pos, int ch, const float* cw, const float* cb) {
    float a = cb[ch];
#pragma unroll
    for (int k = 0; k < 4; ++k) { const int pp = pos - 3 + k; if (pp >= 0) a += cw[k * 768 + ch] * bf2f(projb[(size_t)pp * PN + C_SX + ch]); }
    return siluf_(a);
}
DI void ssd_state_phase(const Params& p, int l, unsigned char* ws, LAS unsigned char* lds, int c, int G) {
    const int tid = otid(), lane = tid & 63, wave = tid >> 6, r32 = lane & 31, hh = lane >> 5;
    const bf16_t* proj = (const bf16_t*)(ws + BIG_PROJ); bf16_t* sst = (bf16_t*)(ws + X_SST); float* cdec = (float*)(ws + X_CDEC);
    const float* cw = p.in[IN_CONVW] + (size_t)l * 4 * 768; const float* cb = p.in[IN_CONVB] + (size_t)l * 768;
    LAS bf16_t* XT = (LAS bf16_t*)lds;
    LAS bf16_t* BT = (LAS bf16_t*)(lds + 64 * 136 * 2);
    LAS float* dtv = (LAS float*)(lds + 192 * 136 * 2);
    for (int it = c; it < NB * 32 * 4; it += G) {
        const int h = it & 3, ch = (it >> 2) & 31, b = it >> 7, g = h >> 1;
        const bf16_t* projb = proj + (size_t)b * SEQ * PN; const int pos0 = ch * 128;
        if (tid < 128) { const float dt = softplusf_(bf2f(projb[(size_t)(pos0 + tid) * PN + C_SDT + h]) + p.in[IN_DTB][l * 4 + h]); dtv[tid] = dt; dtv[128 + tid] = -__expf(p.in[IN_ALOG][l * 4 + h]) * dt; }
        __syncthreads();
        if (tid < 128) { float a = 0.f; for (int j = 0; j <= tid; ++j) a += dtv[128 + j]; dtv[256 + tid] = a; }
        __syncthreads();
        const float alast = dtv[256 + 127];
        if (tid == 0) cdec[(b * 32 + ch) * 4 + h] = __expf(alast);
        { const int pp = tid & 63, lg8 = tid >> 6;
          for (int k = 0; k < 16; ++k) { const int ll = lg8 * 16 + k; const float xs = conv_silu(projb, pos0 + ll, h * 64 + pp, cw, cb); XT[pp * 136 + ll] = f2bf(xs * dtv[ll] * __expf(alast - dtv[256 + ll])); } }
        { const int n = tid & 127, lg4 = tid >> 7;
          for (int k = 0; k < 32; ++k) { const int ll = lg4 * 32 + k; BT[n * 136 + ll] = f2bf(conv_silu(projb, pos0 + ll, 256 + g * 128 + n, cw, cb)); } }
        __syncthreads();
        { const int mi = wave >> 2, ni = wave & 3; f32x16 acc;
#pragma unroll
          for (int r = 0; r < 16; ++r) acc[r] = 0.f;
#pragma unroll
          for (int ks = 0; ks < 8; ++ks) { const bf16x8 a = *(const LAS bf16x8*)(XT + (mi * 32 + r32) * 136 + ks * 16 + hh * 8); const bf16x8 bb = *(const LAS bf16x8*)(BT + (ni * 32 + r32) * 136 + ks * 16 + hh * 8); acc = MFMA32(a, bb, acc); }
          bf16_t* dst = sst + (size_t)((ch * NB + b) * 4 + h) * 8192;
#pragma unroll
          for (int r = 0; r < 16; ++r) dst[(mi * 32 + crow(r, hh)) * 128 + ni * 32 + r32] = f2bf(acc[r]); }
        __syncthreads();
    }
}
DI void ssd_scan_phase(unsigned char* ws, int c, int G) {
    const int tid = otid(); bf16_t* sst = (bf16_t*)(ws + X_SST); const float* cdec = (const float*)(ws + X_CDEC);
    for (int e = c * NTHREADS + tid; e < NB * 4 * 8192; e += G * NTHREADS) {
        const int el = e & 8191, h = (e >> 13) & 3, b = e >> 15; float st = 0.f;
        for (int ch = 0; ch < 32; ++ch) { bf16_t* ptr = sst + (size_t)((ch * NB + b) * 4 + h) * 8192 + el; const float cin = bf2f(*ptr); *ptr = f2bf(st); st = st * cdec[(b * 32 + ch) * 4 + h] + cin; }
    }
}
DI void ssd_out_phase(const Params& p, int l, unsigned char* ws, LAS unsigned char* lds, int c, int G) {
    const int tid = otid(), lane = tid & 63, wave = tid >> 6, r32 = lane & 31, hh = lane >> 5;
    const bf16_t* proj = (const bf16_t*)(ws + BIG_PROJ); const bf16_t* sst = (const bf16_t*)(ws + X_SST); bf16_t* ys = (bf16_t*)(ws + WS_YS);
    const float* cw = p.in[IN_CONVW] + (size_t)l * 4 * 768; const float* cb = p.in[IN_CONVB] + (size_t)l * 768;
    LAS bf16_t* Cn = (LAS bf16_t*)lds;
    LAS bf16_t* Bn = (LAS bf16_t*)(lds + 34816);
    LAS bf16_t* XT = (LAS bf16_t*)(lds + 69632);
    LAS bf16_t* xsn = (LAS bf16_t*)(lds + 87040);
    LAS bf16_t* yb = (LAS bf16_t*)(lds + 103936);
    LAS float* dtv = (LAS float*)(lds + 138752);
    for (int it = c; it < NB * 32 * 2; it += G) {
        const int g = it & 1, ch = (it >> 1) & 31, b = it >> 6;
        const bf16_t* projb = proj + (size_t)b * SEQ * PN; const int pos0 = ch * 128;
        if (tid < 256) { const int hd = tid >> 7, ll = tid & 127, h = 2 * g + hd; const float dt = softplusf_(bf2f(projb[(size_t)(pos0 + ll) * PN + C_SDT + h]) + p.in[IN_DTB][l * 4 + h]); dtv[tid] = dt; dtv[256 + tid] = -__expf(p.in[IN_ALOG][l * 4 + h]) * dt; }
        __syncthreads();
        if (tid < 256) { const int hd = tid >> 7, ll = tid & 127; float a = 0.f; for (int j = 0; j <= ll; ++j) a += dtv[256 + hd * 128 + j]; dtv[512 + tid] = a; }
        { const int n = tid & 127, lg4 = tid >> 7;
          for (int k = 0; k < 32; ++k) { const int ll = lg4 * 32 + k; Bn[ll * 136 + n] = f2bf(conv_silu(projb, pos0 + ll, 256 + g * 128 + n, cw, cb)); Cn[ll * 136 + n] = f2bf(conv_silu(projb, pos0 + ll, 512 + g * 128 + n, cw, cb)); } }
        __syncthreads();
        const int mi = wave >> 1;
        f32x16 cbt[2];
#pragma unroll
        for (int q = 0; q < 2; ++q)
#pragma unroll
            for (int r = 0; r < 16; ++r) cbt[q][r] = 0.f;
#pragma unroll
        for (int ks = 0; ks < 8; ++ks) { const bf16x8 a = *(const LAS bf16x8*)(Cn + (mi * 32 + r32) * 136 + ks * 16 + hh * 8);
#pragma unroll
            for (int q = 0; q < 2; ++q) { const bf16x8 bb = *(const LAS bf16x8*)(Bn + (((wave & 1) * 2 + q) * 32 + r32) * 136 + ks * 16 + hh * 8); cbt[q] = MFMA32(a, bb, cbt[q]); } }
        __syncthreads();
#pragma unroll 1
        for (int hd = 0; hd < 2; ++hd) {
            const int h = 2 * g + hd; LAS float* acs = dtv + 512 + hd * 128; LAS float* dth = dtv + hd * 128;
            { const int pp = tid & 63, lg8 = tid >> 6;
              for (int k = 0; k < 16; ++k) { const int ll = lg8 * 16 + k; const float xs = conv_silu(projb, pos0 + ll, h * 64 + pp, cw, cb); XT[pp * 136 + ll] = f2bf(xs * dth[ll]); xsn[ll * 66 + pp] = f2bf(xs); } }
#pragma unroll
            for (int q = 0; q < 2; ++q) { const int sidx = ((wave & 1) * 2 + q) * 32 + r32; const float as = acs[sidx];
#pragma unroll
                for (int r = 0; r < 16; ++r) { const int li = mi * 32 + crow(r, hh); const float lm = li >= sidx ? __expf(acs[li] - as) : 0.f; Bn[li * 136 + sidx] = f2bf(cbt[q][r] * lm); } }
            __syncthreads();
            { const int ni = wave & 1; f32x16 yd, yo;
#pragma unroll
              for (int r = 0; r < 16; ++r) { yd[r] = 0.f; yo[r] = 0.f; }
              const bf16_t* prev = sst + (size_t)((ch * NB + b) * 4 + h) * 8192 + (size_t)(ni * 32 + r32) * 128 + hh * 8;
#pragma unroll
              for (int ks = 0; ks < 8; ++ks) { const bf16x8 a = *(const LAS bf16x8*)(Bn + (mi * 32 + r32) * 136 + ks * 16 + hh * 8); const bf16x8 bb = *(const LAS bf16x8*)(XT + (ni * 32 + r32) * 136 + ks * 16 + hh * 8); yd = MFMA32(a, bb, yd);
                  const bf16x8 a2 = *(const LAS bf16x8*)(Cn + (mi * 32 + r32) * 136 + ks * 16 + hh * 8); const bf16x8 b2 = *(const bf16x8*)(prev + ks * 16); yo = MFMA32(a2, b2, yo); }
              const int pp = ni * 32 + r32; const float dsk = p.in[IN_DSKIP][l * 4 + h];
#pragma unroll
              for (int r = 0; r < 16; ++r) { const int li = mi * 32 + crow(r, hh); const float z = bf2f(projb[(size_t)(pos0 + li) * PN + C_SZ + h * 64 + pp]);
                  const float y = yd[r] + __expf(acs[li]) * yo[r] + bf2f(xsn[li * 66 + pp]) * dsk; yb[li * 136 + hd * 64 + pp] = f2bf(y * siluf_(z)); } }
            __syncthreads();
        }
        { const int li = tid >> 2, q4 = tid & 3; float v[32], ss = 0.f;
#pragma unroll
          for (int k = 0; k < 32; ++k) { v[k] = bf2f(yb[li * 136 + q4 * 32 + k]); ss += v[k] * v[k]; }
          ss += __shfl_xor(ss, 1); ss += __shfl_xor(ss, 2); const float rs = 1.0f / sqrtf(ss * (1.f / 128.f) + LN_EPS);
          const float* ng = p.in[IN_SNG] + (size_t)l * 256 + g * 128 + q4 * 32; bf16_t* yrow = ys + (size_t)(b * SEQ + pos0 + li) * DM + 768 + g * 128 + q4 * 32;
#pragma unroll
          for (int k = 0; k < 32; ++k) yrow[k] = f2bf(v[k] * rs * ng[k]); }
        __syncthreads();
    }
}

constexpr int L_PST = 131072, L_RED = L_PST + 20480, L_MISC = L_RED + 2304;
template <class Mask, bool SAVE_E>
DI void mqa_attn(LAS unsigned char* lds, int tid, const bf16_t* qbase, const bf16_t* kbase, int kstride, const bf16_t* vT, int vstride, int tile_lo, int tile_hi, float scale,
                 const Mask& mask, LAS float* oslot, LAS float* lsum, LAS float* esave, int estr) {
    tid = launder(tid);
    const int lane = tid & 63, wave = tid >> 6, r32 = lane & 31, hh = lane >> 5;
    LAS bf16_t* Pst = (LAS bf16_t*)(lds + L_PST + wave * 2560);
    LAS float* redm = (LAS float*)(lds + L_RED); LAS float* redl = redm + 256;
    bf16x8 qa[4];
#pragma unroll
    for (int ks = 0; ks < 4; ++ks) qa[ks] = *(const bf16x8*)(qbase + (size_t)(r32 >> 2) * PN + (r32 & 3) * 64 + ks * 16 + hh * 8);
    float m[16];
#pragma unroll
    for (int r = 0; r < 16; ++r) m[r] = -1e30f;
    bf16x8 kf[4];
    { const int t1 = tile_lo + wave < tile_hi ? tile_lo + wave : tile_lo; const bf16_t* kp = kbase + (size_t)(t1 * 32 + r32) * kstride + hh * 8;
#pragma unroll
      for (int ks = 0; ks < 4; ++ks) kf[ks] = *(const bf16x8*)(kp + ks * 16); }
#pragma unroll 1
    for (int tile = tile_lo + wave; tile < tile_hi; tile += 8) {
        const int key = tile * 32 + r32; const int nxt = tile + 8 < tile_hi ? tile + 8 : tile; const bf16_t* kp = kbase + (size_t)(nxt * 32 + r32) * kstride + hh * 8;
        bf16x8 kn[4];
#pragma unroll
        for (int ks = 0; ks < 4; ++ks) kn[ks] = *(const bf16x8*)(kp + ks * 16);
        f32x16 S;
#pragma unroll
        for (int r = 0; r < 16; ++r) S[r] = 0.f;
#pragma unroll
        for (int ks = 0; ks < 4; ++ks) S = MFMA32(qa[ks], kf[ks], S);
#pragma unroll
        for (int g = 0; g < 4; ++g) { const bool ok = mask(2 * g + hh, key);
#pragma unroll
            for (int i = 0; i < 4; ++i) m[4 * g + i] = ok ? fmaxf(m[4 * g + i], S[4 * g + i]) : m[4 * g + i]; }
#pragma unroll
        for (int ks = 0; ks < 4; ++ks) kf[ks] = kn[ks];
    }
#pragma unroll
    for (int r = 0; r < 16; ++r) { m[r] = half_max(m[r]); if (r32 == 0) redm[wave * 32 + crow(r, hh)] = m[r]; }
    __syncthreads();
    LAS float* mfin = (LAS float*)(lds + L_RED + 2048);
    if (tid < 32) { float mm = redm[tid];
#pragma unroll
        for (int w = 1; w < 8; ++w) mm = fmaxf(mm, redm[w * 32 + tid]);
        mfin[tid] = mm; }
    __syncthreads();
#pragma unroll
    for (int r = 0; r < 16; ++r) m[r] = mfin[crow(r, hh)];
    float lr[16]; f32x16 O[2]; const float c1 = scale * 1.4426950408889634f;
#pragma unroll
    for (int r = 0; r < 16; ++r) { lr[r] = 0.f; O[0][r] = 0.f; O[1][r] = 0.f; m[r] *= c1; }
    bf16x8 vf[4];
    { const int t1 = tile_lo + wave < tile_hi ? tile_lo + wave : tile_lo; const bf16_t* kp = kbase + (size_t)(t1 * 32 + r32) * kstride + hh * 8;
#pragma unroll
      for (int ks = 0; ks < 4; ++ks) kf[ks] = *(const bf16x8*)(kp + ks * 16);
#pragma unroll
      for (int q = 0; q < 4; ++q) vf[q] = *(const bf16x8*)(vT + (size_t)((q & 1) * 32 + r32) * vstride + t1 * 32 + (q >> 1) * 16 + hh * 8); }
#pragma unroll 1
    for (int tile = tile_lo + wave; tile < tile_hi; tile += 8) {
        const int key = tile * 32 + r32; const int nxt = tile + 8 < tile_hi ? tile + 8 : tile; const bf16_t* kp = kbase + (size_t)(nxt * 32 + r32) * kstride + hh * 8;
        bf16x8 kn[4], vn[4];
#pragma unroll
        for (int ks = 0; ks < 4; ++ks) kn[ks] = *(const bf16x8*)(kp + ks * 16);
#pragma unroll
        for (int q = 0; q < 4; ++q) vn[q] = *(const bf16x8*)(vT + (size_t)((q & 1) * 32 + r32) * vstride + nxt * 32 + (q >> 1) * 16 + hh * 8);
        f32x16 S;
#pragma unroll
        for (int r = 0; r < 16; ++r) S[r] = 0.f;
#pragma unroll
        for (int ks = 0; ks < 4; ++ks) S = MFMA32(qa[ks], kf[ks], S);
#pragma unroll
        for (int g = 0; g < 4; ++g) { const bool ok = mask(2 * g + hh, key);
#pragma unroll
            for (int i = 0; i < 4; ++i) { const int r = 4 * g + i; const float pe = ok ? __builtin_amdgcn_exp2f(__builtin_fmaf(S[r], c1, -m[r])) : 0.f; lr[r] += pe; Pst[crow(r, hh) * 40 + r32] = (bf16_t)pk2(pe, 0.f);
                if (SAVE_E) esave[crow(r, hh) * estr + key] = pe; } }
#pragma unroll
        for (int ks = 0; ks < 2; ++ks) { const bf16x8 a = *(const LAS bf16x8*)(Pst + r32 * 40 + ks * 16 + hh * 8);
#pragma unroll
            for (int n = 0; n < 2; ++n) O[n] = MFMA32(a, vf[ks * 2 + n], O[n]); }
#pragma unroll
        for (int ks = 0; ks < 4; ++ks) { kf[ks] = kn[ks]; vf[ks] = vn[ks]; }
    }
#pragma unroll
    for (int r = 0; r < 16; ++r) { lr[r] = half_sum(lr[r]); if (r32 == 0) redl[wave * 32 + crow(r, hh)] = lr[r]; }
    __syncthreads();
    LAS float* part = (LAS float*)lds;
#pragma unroll
    for (int n = 0; n < 2; ++n)
#pragma unroll
        for (int r = 0; r < 16; ++r) part[(wave * 32 + crow(r, hh)) * 64 + n * 32 + r32] = O[n][r];
    __syncthreads();
    { const int row = tid >> 4, d4 = (tid & 15) * 4; f32x4 a = {0.f, 0.f, 0.f, 0.f}; float L = 0.f;
#pragma unroll
      for (int w = 0; w < 8; ++w) { a += *(const LAS f32x4*)(part + (w * 32 + row) * 64 + d4); L += redl[w * 32 + row]; }
      const float inv = 1.0f / fmaxf(L, 1e-30f);
      *(LAS f32x4*)(oslot + row * 64 + d4) = a * inv; if ((tid & 15) == 0) lsum[row] = L; }
    __syncthreads();
}
DI void item_map(int j, int c, int G, int& b, int& t0, bool& valid) { const int idx = j * G + ((j & 1) ? (G - 1 - c) : c); valid = idx < 2048; b = idx & 3; t0 = (idx >> 2) * 8; }

DI unsigned sort_key(float f) { f = f + 0.0f; const unsigned u = __float_as_uint(f); return (u >> 31) ? ~u : (u | 0x80000000u); }
template <int NR> DI void dsa_select(const LAS float* srow, int t, int lane, unsigned& T_out, int& cut_out) {
    unsigned v[NR];
#pragma unroll
    for (int j = 0; j < NR; ++j) { const int sidx = lane + 64 * j; v[j] = sidx <= t ? sort_key(srow[sidx]) : 0u; }
    unsigned T = 0;
#pragma unroll 1
    for (int bit = 31; bit >= 0; --bit) { const unsigned cand = T | (1u << bit); int cnt = 0;
#pragma unroll
        for (int j = 0; j < NR; ++j) cnt += __popcll(__ballot(v[j] >= cand));
        if (cnt >= 256) T = cand;
        if (cnt == 256) { T_out = T; cut_out = 4095; return; } }
    int cgt = 0, ceq = 0;
#pragma unroll
    for (int j = 0; j < NR; ++j) { cgt += __popcll(__ballot(v[j] > T)); ceq += __popcll(__ballot(v[j] == T)); }
    int cut = 4095; const int need = 256 - cgt;
    if (ceq > need) { int cc = 0;
#pragma unroll 1
        for (int bit = 11; bit >= 0; --bit) { const int cand = cc | (1 << bit); int cnt = 0;
#pragma unroll
            for (int j = 0; j < NR; ++j) cnt += __popcll(__ballot(v[j] == T && (lane + 64 * j) < cand));
            if (cnt < need) cc = cand; }
        cut = cc; }
    T_out = T; cut_out = cut;
}
struct DsaMask { int t0; const LAS float* sc; const LAS unsigned* thr; const LAS int* cut;
    DI bool operator()(int tl, int key) const { const unsigned u = sort_key(sc[tl * 4096 + key]), T = thr[tl]; return key <= t0 + tl && (u > T || (u == T && key <= cut[tl])); } };
DI void dsa_phase(unsigned char* ws, LAS unsigned char* lds, int c, int G) {
    const int tid = otid(), lane = tid & 63, wave = tid >> 6, r32 = lane & 31, hh = lane >> 5;
    const bf16_t* proj = (const bf16_t*)(ws + BIG_PROJ); bf16_t* ys = (bf16_t*)(ws + WS_YS);
    LAS float* sc = (LAS float*)lds; LAS unsigned* thr = (LAS unsigned*)(lds + L_MISC); LAS int* cut = (LAS int*)(lds + L_MISC + 64); LAS float* lsum = (LAS float*)(lds + L_MISC + 128);
    LAS float* oslot = (LAS float*)(lds + 65536);
    const int rounds = (2048 + G - 1) / G;
    for (int j = 0; j < rounds; ++j) {
        int b, t0; bool valid; item_map(j, c, G, b, t0, valid); if (!valid) continue;
        const bf16_t* projb = proj + (size_t)b * SEQ * PN; const int nt = t0 / 32 + 1;
        {
            const int tq = launder(tid), lane = tq & 63, wave = tq >> 6, r32 = lane & 31, hh = lane >> 5;
            bf16x8 ia[2][2]; float w[2][4][4];
#pragma unroll
            for (int mt = 0; mt < 2; ++mt) {
#pragma unroll
                for (int ks = 0; ks < 2; ++ks) ia[mt][ks] = *(const bf16x8*)(projb + (size_t)(t0 + mt * 4 + (r32 >> 3)) * PN + C_IQ + (r32 & 7) * 32 + ks * 16 + hh * 8);
#pragma unroll
                for (int g = 0; g < 4; ++g)
#pragma unroll
                    for (int i = 0; i < 4; ++i) w[mt][g][i] = bf2f(projb[(size_t)(t0 + mt * 4 + g) * PN + C_IW + 4 * hh + i]) * 0.0625f;
            }
            for (int tile = wave; tile < nt; tile += 8) {
                const int key = tile * 32 + r32; const bf16_t* kp = projb + (size_t)key * PN + C_IK + hh * 8;
                const bf16x8 b0 = *(const bf16x8*)kp, b1 = *(const bf16x8*)(kp + 16);
#pragma unroll
                for (int mt = 0; mt < 2; ++mt) { f32x16 a;
#pragma unroll
                    for (int r = 0; r < 16; ++r) a[r] = 0.f;
                    a = MFMA32(ia[mt][0], b0, a); a = MFMA32(ia[mt][1], b1, a);
#pragma unroll
                    for (int g = 0; g < 4; ++g) { float v = 0.f;
#pragma unroll
                        for (int i = 0; i < 4; ++i) v += w[mt][g][i] * fmaxf(a[4 * g + i], 0.f);
                        v += __shfl_xor(v, 32);
                        if (hh == mt) sc[(mt * 4 + g) * 4096 + key] = v; } }
            }
        }
        __syncthreads();
        { const int tq = launder(tid), lane = tq & 63, wave = tq >> 6; const int t = t0 + wave; unsigned T; int cu; const LAS float* srow = sc + wave * 4096;
          if (t < 256) { T = 0u; cu = 4095; }
          else if (t < 1024) dsa_select<16>(srow, t, lane, T, cu);
          else if (t < 2048) dsa_select<32>(srow, t, lane, T, cu);
          else if (t < 3072) dsa_select<48>(srow, t, lane, T, cu);
          else dsa_select<64>(srow, t, lane, T, cu);
          if (lane == 0) { thr[wave] = T; cut[wave] = cu; } }
        __syncthreads();
        DsaMask mk{t0, sc, thr, cut};
        mqa_attn<DsaMask, false>(lds, tid, projb + (size_t)t0 * PN + C_DQ, projb + C_DK, PN, (const bf16_t*)(ws + X_DVT) + (size_t)b * 64 * SEQ, SEQ, 0, nt, 0.125f, mk, oslot, lsum, nullptr, 0);
        { const int row = tid >> 4, d4 = (tid & 15) * 4; const f32x4 o = *(const LAS f32x4*)(oslot + row * 64 + d4); u32x2 wv; wv.x = pk2(o[0], o[1]); wv.y = pk2(o[2], o[3]);
          *(u32x2*)(ys + (size_t)(b * SEQ + t0 + (row >> 2)) * DM + 256 + (row & 3) * 64 + d4) = wv; }
        __syncthreads();
    }
}

struct CmpMask { int t0; DI bool operator()(int tl, int key) const { return key <= 254 && 16 * key + 31 <= t0 + tl; } };
struct SelMask { int t0; const LAS unsigned* sel; DI bool operator()(int tl, int key) const { const int blk = key >> 6; return key <= t0 + tl && ((sel[tl * 2 + (blk >> 5)] >> (blk & 31)) & 1u); } };
struct WinMask { int t0; DI bool operator()(int tl, int key) const { const int t = t0 + tl; return key <= t && t - key < 512; } };
template <class Mask>
DI void wave_attn(const bf16x8 (&qa)[4], const bf16_t* kbase, int kstride, const bf16_t* vT, int vstride, int tile_lo, int tile_hi, float c1, const Mask& mask,
                  LAS bf16_t* Pst, int r32, int hh, f32x16 (&O)[2], float (&lr)[16], float (&mc)[16]) {
#pragma unroll
    for (int r = 0; r < 16; ++r) { mc[r] = -1e30f; lr[r] = 0.f; O[0][r] = 0.f; O[1][r] = 0.f; }
    bf16x8 kf[4];
    { const bf16_t* kp = kbase + (size_t)(tile_lo * 32 + r32) * kstride + hh * 8;
#pragma unroll
      for (int ks = 0; ks < 4; ++ks) kf[ks] = *(const bf16x8*)(kp + ks * 16); }
#pragma unroll 1
    for (int tile = tile_lo; tile < tile_hi; ++tile) {
        const int key = tile * 32 + r32; const int nxt = tile + 1 < tile_hi ? tile + 1 : tile; const bf16_t* kp = kbase + (size_t)(nxt * 32 + r32) * kstride + hh * 8;
        bf16x8 kn[4];
#pragma unroll
        for (int ks = 0; ks < 4; ++ks) kn[ks] = *(const bf16x8*)(kp + ks * 16);
        f32x16 S;
#pragma unroll
        for (int r = 0; r < 16; ++r) S[r] = 0.f;
#pragma unroll
        for (int ks = 0; ks < 4; ++ks) S = MFMA32(qa[ks], kf[ks], S);
#pragma unroll
        for (int g = 0; g < 4; ++g) { const bool ok = mask(g, key);
#pragma unroll
            for (int i = 0; i < 4; ++i) mc[4 * g + i] = ok ? fmaxf(mc[4 * g + i], S[4 * g + i]) : mc[4 * g + i]; }
#pragma unroll
        for (int ks = 0; ks < 4; ++ks) kf[ks] = kn[ks];
    }
#pragma unroll
    for (int r = 0; r < 16; ++r) mc[r] = half_max(mc[r]) * c1;
    { const bf16_t* kp = kbase + (size_t)(tile_lo * 32 + r32) * kstride + hh * 8;
#pragma unroll
      for (int ks = 0; ks < 4; ++ks) kf[ks] = *(const bf16x8*)(kp + ks * 16); }
#pragma unroll 1
    for (int tile = tile_lo; tile < tile_hi; ++tile) {
        const int key = tile * 32 + r32; const int nxt = tile + 1 < tile_hi ? tile + 1 : tile; const bf16_t* kp = kbase + (size_t)(nxt * 32 + r32) * kstride + hh * 8;
        bf16x8 kn[4], vf[4];
#pragma unroll
        for (int ks = 0; ks < 4; ++ks) kn[ks] = *(const bf16x8*)(kp + ks * 16);
#pragma unroll
        for (int q = 0; q < 4; ++q) vf[q] = *(const bf16x8*)(vT + (size_t)((q & 1) * 32 + r32) * vstride + tile * 32 + (q >> 1) * 16 + hh * 8);
        f32x16 S;
#pragma unroll
        for (int r = 0; r < 16; ++r) S[r] = 0.f;
#pragma unroll
        for (int ks = 0; ks < 4; ++ks) S = MFMA32(qa[ks], kf[ks], S);
#pragma unroll
        for (int g = 0; g < 4; ++g) { const bool ok = mask(g, key);
#pragma unroll
            for (int i = 0; i < 4; ++i) { const int r = 4 * g + i; const float pe = ok ? __builtin_amdgcn_exp2f(__builtin_fmaf(S[r], c1, -mc[r])) : 0.f; lr[r] += pe; Pst[crow(r, hh) * 40 + r32] = (bf16_t)pk2(pe, 0.f); } }
#pragma unroll
        for (int ks = 0; ks < 2; ++ks) { const bf16x8 a = *(const LAS bf16x8*)(Pst + r32 * 40 + ks * 16 + hh * 8);
#pragma unroll
            for (int n = 0; n < 2; ++n) O[n] = MFMA32(a, vf[ks * 2 + n], O[n]); }
#pragma unroll
        for (int ks = 0; ks < 4; ++ks) kf[ks] = kn[ks];
    }
#pragma unroll
    for (int r = 0; r < 16; ++r) lr[r] = 1.0f / fmaxf(half_sum(lr[r]), 1e-30f);
}
struct WCmpMask { int tq[4]; DI bool operator()(int g, int key) const { return key <= 254 && 16 * key + 31 <= tq[g]; } };
struct WSelMask { int tq[4]; unsigned long long sel[4]; DI bool operator()(int g, int key) const { return key <= tq[g] && ((sel[g] >> (key >> 6)) & 1ull); } };
struct WWinMask { int tq[4]; DI bool operator()(int g, int key) const { return key <= tq[g] && tq[g] - key < 512; } };
DI void nsa_phase(unsigned char* ws, LAS unsigned char* lds, int c, int G) {
    const int tid = otid(), lane = tid & 63, wave = tid >> 6, r32 = lane & 31, hh = lane >> 5;
    const bf16_t* proj = (const bf16_t*)(ws + BIG_PROJ); bf16_t* ys = (bf16_t*)(ws + WS_YS);
    LAS unsigned char* wl = lds + wave * 19264;
    LAS bf16_t* Pst = (LAS bf16_t*)wl; LAS float* pc = (LAS float*)(wl + 2560); LAS float* impv = (LAS float*)(wl + 2560 + 8192); LAS unsigned* selw = (LAS unsigned*)(wl + 2560 + 8192 + 256); LAS float* outl = (LAS float*)(wl + 2560 + 8192 + 256 + 64) + lane;
    const float c1 = 0.125f * 1.4426950408889634f;
    for (int it = wave * G + c; it < 2048; it += NWAVES * G) {
        const int b = it & 3, t0 = (it >> 2) * 8;
        const bf16_t* projb = proj + (size_t)b * SEQ * PN; const int nt = t0 / 32 + 1; const bf16_t* qb = projb + (size_t)t0 * PN + C_NQ;
        bf16x8 qa[4];
#pragma unroll
        for (int ks = 0; ks < 4; ++ks) qa[ks] = *(const bf16x8*)(qb + (size_t)(r32 >> 2) * PN + (r32 & 3) * 64 + ks * 16 + hh * 8);
        f32x16 O[2]; float lr[16], mc[16];
        const bf16_t* kc = (const bf16_t*)(ws + S_KCMP) + (size_t)b * 256 * 64; const bf16_t* vc = (const bf16_t*)(ws + S_VCMPT) + (size_t)b * 64 * 256;
        WCmpMask cm;
#pragma unroll
        for (int g = 0; g < 4; ++g) cm.tq[g] = t0 + 2 * g + hh;
        wave_attn(qa, kc, 64, vc, 256, 0, 8, c1, cm, Pst, r32, hh, O, lr, mc);
#pragma unroll
        for (int r = 0; r < 16; ++r) { const float gt = sigmoidf_(bf2f(projb[(size_t)(t0 + 2 * (r >> 2) + hh) * PN + C_NG + (r & 3) * 3 + 0])) * lr[r]; outl[r * 64] = gt * O[0][r]; outl[(16 + r) * 64] = gt * O[1][r]; }
#pragma unroll 1
        for (int tile = 0; tile < 8; ++tile) {
            const int key = tile * 32 + r32; const bf16_t* kp = kc + (size_t)key * 64 + hh * 8;
            f32x16 S;
#pragma unroll
            for (int r = 0; r < 16; ++r) S[r] = 0.f;
#pragma unroll
            for (int ks = 0; ks < 4; ++ks) S = MFMA32(qa[ks], *(const bf16x8*)(kp + ks * 16), S);
#pragma unroll
            for (int g = 0; g < 4; ++g) { const bool ok = cm(g, key); float v = 0.f;
#pragma unroll
                for (int i = 0; i < 4; ++i) { const int r = 4 * g + i; v += ok ? __builtin_amdgcn_exp2f(__builtin_fmaf(S[r], c1, -mc[r])) * lr[r] : 0.f; }
                pc[(2 * g + hh) * 256 + key] = v; }
        }
#pragma unroll 1
        for (int tl = 0; tl < 8; ++tl) {
            const int jb = lane, t = t0 + tl, cur = t >> 6; float imp = 0.f;
#pragma unroll
            for (int k = -1; k < 4; ++k) { const int ci = 4 * jb + k; if (ci >= 0 && ci < 255) { const float pv = pc[tl * 256 + ci]; imp += (k == -1 || k == 3) ? 0.5f * pv : pv; } }
            const bool forced = jb == 0 || jb == cur || jb == cur - 1, adm = jb <= cur;
            const float val = adm ? (forced ? __builtin_inff() : imp) : -__builtin_inff();
            impv[jb] = val;
            int rank = 0;
            for (int q = 0; q < 64; ++q) { const float o = impv[q]; rank += (o > val || (o == val && q < jb)) ? 1 : 0; }
            const unsigned long long bal = __ballot(rank < 16);
            if (lane == 0) { selw[tl * 2] = (unsigned)bal; selw[tl * 2 + 1] = (unsigned)(bal >> 32); }
        }
        { WSelMask sm;
#pragma unroll
          for (int g = 0; g < 4; ++g) { sm.tq[g] = t0 + 2 * g + hh; sm.sel[g] = (unsigned long long)selw[(2 * g + hh) * 2] | ((unsigned long long)selw[(2 * g + hh) * 2 + 1] << 32); }
          wave_attn(qa, projb + C_NKS, PN, (const bf16_t*)(ws + X_NVST) + (size_t)b * 64 * SEQ, SEQ, 0, nt, c1, sm, Pst, r32, hh, O, lr, mc); }
#pragma unroll
        for (int r = 0; r < 16; ++r) { const float gt = sigmoidf_(bf2f(projb[(size_t)(t0 + 2 * (r >> 2) + hh) * PN + C_NG + (r & 3) * 3 + 1])) * lr[r]; outl[r * 64] += gt * O[0][r]; outl[(16 + r) * 64] += gt * O[1][r]; }
        { WWinMask wm;
#pragma unroll
          for (int g = 0; g < 4; ++g) wm.tq[g] = t0 + 2 * g + hh;
          const int tlo = (t0 > 511 ? t0 - 511 : 0) >> 5;
          wave_attn(qa, projb + C_NKW, PN, (const bf16_t*)(ws + X_NVWT) + (size_t)b * 64 * SEQ, SEQ, tlo, nt, c1, wm, Pst, r32, hh, O, lr, mc); }
#pragma unroll
        for (int r = 0; r < 16; ++r) { const float gt = sigmoidf_(bf2f(projb[(size_t)(t0 + 2 * (r >> 2) + hh) * PN + C_NG + (r & 3) * 3 + 2])) * lr[r];
            bf16_t* yp = ys + (size_t)(b * SEQ + t0 + 2 * (r >> 2) + hh) * DM + 512 + (r & 3) * 64 + r32; yp[0] = f2bf(outl[r * 64] + gt * O[0][r]); yp[32] = f2bf(outl[(16 + r) * 64] + gt * O[1][r]); }
    }
    __syncthreads();
}

struct MergeOrder {
    int G, c; long a_ys, b_wb;
    DI bool next(int i, pg8::Unit& u) const {
        const int tile = c + (i >> 3) * G; if (tile >= 256) return false;
        const int sub = i & 7, b = sub >> 1, kind = sub & 1; u.pm = tile >> 2; u.pn = tile & 3; u.aux = sub;
        if (kind == 0) { u.aoff = 0; u.boff = (long)b * 1024 * 1024 * 2; u.nt = 16; } else { u.aoff = a_ys + b * 512; u.boff = b_wb + b * 512; u.nt = 4; }
        return true;
    }
};
struct EpiMerge {
    static constexpr bool PERM = true;
    bf16_t* gbuf; bf16_t* merged;
    DI void operator()(const f32x4 (&acc)[2][2][4][2], const pg8::Unit& u, int wr, int wc, int fr, int fq) const {
        const int row0 = u.pm * 256 + wr * 64 + fr, col0 = u.pn * 256 + wc * 32 + 8 * fq; const int kind = u.aux & 1, b = u.aux >> 1;
#pragma unroll
        for (int ai = 0; ai < 2; ++ai)
#pragma unroll
            for (int m = 0; m < 4; ++m) { const size_t ro = (size_t)(row0 + ai * 128 + m * 16) * DM + col0;
#pragma unroll
                for (int bj = 0; bj < 2; ++bj) { const f32x4 v0 = acc[ai][bj][m][0], v1 = acc[ai][bj][m][1]; const size_t off = ro + bj * 128;
                    if (kind == 0) { u32x4 w; w.x = pk2(sigmoidf_(v0[0]), sigmoidf_(v0[1])); w.y = pk2(sigmoidf_(v0[2]), sigmoidf_(v0[3])); w.z = pk2(sigmoidf_(v1[0]), sigmoidf_(v1[1])); w.w = pk2(sigmoidf_(v1[2]), sigmoidf_(v1[3]));
                        *(u32x4*)(gbuf + off) = w; }
                    else { const u32x4 gq = *(const u32x4*)(gbuf + off); u32x4 pq = {0u, 0u, 0u, 0u}; if (b > 0) pq = *(const u32x4*)(merged + off);
                        float r[8];
                        r[0] = __uint_as_float(gq.x << 16) * v0[0] + __uint_as_float(pq.x << 16); r[1] = __uint_as_float(gq.x & 0xffff0000u) * v0[1] + __uint_as_float(pq.x & 0xffff0000u);
                        r[2] = __uint_as_float(gq.y << 16) * v0[2] + __uint_as_float(pq.y << 16); r[3] = __uint_as_float(gq.y & 0xffff0000u) * v0[3] + __uint_as_float(pq.y & 0xffff0000u);
                        r[4] = __uint_as_float(gq.z << 16) * v1[0] + __uint_as_float(pq.z << 16); r[5] = __uint_as_float(gq.z & 0xffff0000u) * v1[1] + __uint_as_float(pq.z & 0xffff0000u);
                        r[6] = __uint_as_float(gq.w << 16) * v1[2] + __uint_as_float(pq.w << 16); r[7] = __uint_as_float(gq.w & 0xffff0000u) * v1[3] + __uint_as_float(pq.w & 0xffff0000u);
                        u32x4 w; w.x = pk2(r[0], r[1]); w.y = pk2(r[2], r[3]); w.z = pk2(r[4], r[5]); w.w = pk2(r[6], r[7]);
                        *(u32x4*)(merged + off) = w; } } }
    }
};


DI void cvt_wmix(const Params& p, int l, LAS unsigned char* lds, int c, int G) {
    unsigned char* ws = p.ws;
    cvt_matrix(p.in[IN_WIN] + (size_t)l * DM * DIN, DM, DIN, (bf16_t*)(ws + W_IN), PN, MAP_IN, lds, c, G);
    cvt_matrix(p.in[IN_WIN] + (size_t)l * DM * DIN, DM, DIN, (bf16_t*)(ws + W_G), 4096, MAP_GATE, lds, c, G);
    cvt_matrix(p.in[IN_WBR] + (size_t)l * DM * DM, DM, DM, (bf16_t*)(ws + W_B), DM, MAP_ID, lds, c, G);
    cvt_matrix(p.in[IN_WOUT] + (size_t)l * DM * DM, DM, DM, (bf16_t*)(ws + W_OUT), DM, MAP_ID, lds, c, G);
    cvt_matrix(p.in[IN_XQ] + (size_t)l * DM * DM, DM, DM, (bf16_t*)(ws + W_Q), DM, MAP_ID, lds, c, G);
    cvt_matrix(p.in[IN_XKV] + (size_t)l * DM * 2 * DM, DM, 2 * DM, (bf16_t*)(ws + W_KV), 2 * DM, MAP_ID, lds, c, G);
    cvt_matrix(p.in[IN_XO] + (size_t)l * DM * DM, DM, DM, (bf16_t*)(ws + W_O), DM, MAP_ID, lds, c, G);
    for (int i = 0; i < 2; ++i) {
        cvt_matrix(p.in[IN_C1] + (size_t)(l * 2 + i) * 2048 * 64, 2048, 64, (bf16_t*)(ws + W_C1) + (size_t)i * 64 * 2048, 64, MAP_ID, lds, c, G);
        cvt_matrix(p.in[IN_C2] + (size_t)(l * 2 + i) * 64 * 64, 64, 64, (bf16_t*)(ws + W_C2) + (size_t)i * 64 * 64, 64, MAP_ID, lds, c, G);
    }
}

template <int l> DI void layer_body(const Params& p, const XcdBarrier& xbar, LAS unsigned char* lds, int c, int G) {
    unsigned char* ws = p.ws;
    float* xf = (float*)(ws + WS_XF); bf16_t* xb = (bf16_t*)(ws + WS_XB);

        const float* lng = p.in[IN_LNG] + (size_t)l * 4 * DM; const float* lnb = p.in[IN_LNB] + (size_t)l * 4 * DM;
        { pg8::TileOrder S; S.init(NTOK, 2 * DFF, DM, G, c); pg8::Gemm g{xb, (const bf16_t*)(ws + W_GU), DM, DM}; pg8::EpiSwiGLU E{(bf16_t*)(ws + BIG_H)}; pg8::gemm_phase(lds, g, S, E); }
        xcd_barrier(xbar);
        { pg8::TileOrder S; S.init(NTOK, DM, DFF, G, c); pg8::Gemm g{(const bf16_t*)(ws + BIG_H), (const bf16_t*)(ws + W_DOWN), DFF, DFF}; pg8::EpiResid E{xf, 0.5f}; pg8::gemm_phase(lds, g, S, E); }
        xcd_barrier(xbar);
        ln_phase(xf, xb, nullptr, lng, lnb, c, G);
        xcd_barrier(xbar);
        { pg8::TileOrder S; S.init(NTOK, PN, DM, G, c); pg8::Gemm g{xb, (const bf16_t*)(ws + W_IN), DM, DM}; pg8::EpiBf16 E{(bf16_t*)(ws + BIG_PROJ), PN}; pg8::gemm_phase(lds, g, S, E); }
        xcd_barrier(xbar);
        prep_phase(ws, lds, c, G);
        xcd_barrier(xbar);
        compress_phase(p, l, ws, lds, c, G);
        ret_state_phase(ws, c, G);
        ssd_state_phase(p, l, ws, lds, c, G);
        xcd_barrier(xbar);
        ret_scan_phase(ws, c, G);
        ssd_scan_phase(ws, c, G);
        xcd_barrier(xbar);
        ret_out_phase(ws, lds, c, G);
        ssd_out_phase(p, l, ws, lds, c, G);
        dsa_phase(ws, lds, c, G);
        nsa_phase(ws, lds, c, G);
        xcd_barrier(xbar);
        { MergeOrder S{G, c, (long)WS_YS - (long)WS_XB, (long)W_B - (long)W_G}; pg8::Gemm g{xb, (const bf16_t*)(ws + W_G), DM, DM}; EpiMerge E{(bf16_t*)(ws + BIG_GBUF), (bf16_t*)(ws + BIG_MERGED)}; pg8::gemm_phase(lds, g, S, E); }
        xcd_barrier(xbar);
        { pg8::TileOrder S; S.init(NTOK, DM, DM, G, c); pg8::Gemm g{(const bf16_t*)(ws + BIG_MERGED), (const bf16_t*)(ws + W_OUT), DM, DM}; pg8::EpiResid E{xf, 1.0f}; pg8::gemm_phase(lds, g, S, E); }
        xcd_barrier(xbar);
        ln_phase(xf, xb, nullptr, lng + DM, lnb + DM, c, G);
        cvt_matrix(p.in[IN_F2GU] + (size_t)l * DM * 2 * DFF, DM, 2 * DFF, (bf16_t*)(ws + W_GU), 2 * DFF, MAP_GU, lds, c, G);
        cvt_matrix(p.in[IN_F2DN] + (size_t)l * DFF * DM, DFF, DM, (bf16_t*)(ws + W_DOWN), DM, MAP_ID, lds, c, G);
        xcd_barrier(xbar);
        { pg8::TileOrder S; S.init(NTOK, DM, DM, G, c); pg8::Gemm g{xb, (const bf16_t*)(ws + W_Q), DM, DM}; pg8::EpiBf16 E{(bf16_t*)(ws + BIG_QX), DM}; pg8::gemm_phase(lds, g, S, E); }
        { pg8::TileOrder S; S.init(NB * NMEM, 2 * DM, DM, G, c); pg8::Gemm g{(const bf16_t*)(ws + S_MEMB), (const bf16_t*)(ws + W_KV), DM, DM}; EpiKV E{(bf16_t*)(ws + S_KVX), (bf16_t*)(ws + S_KVX + 2 * MiB)}; pg8::gemm_phase(lds, g, S, E); }
        xcd_barrier(xbar);
        xattn_phase((const bf16_t*)(ws + BIG_QX), (const bf16_t*)(ws + S_KVX), (const bf16_t*)(ws + S_KVX + 2 * MiB), (bf16_t*)(ws + BIG_AO), lds, c, G);
        xcd_barrier(xbar);
        { pg8::TileOrder S; S.init(NTOK, DM, DM, G, c); pg8::Gemm g{(const bf16_t*)(ws + BIG_AO), (const bf16_t*)(ws + W_O), DM, DM}; pg8::EpiResid E{xf, 1.0f}; pg8::gemm_phase(lds, g, S, E); }
        xcd_barrier(xbar);
        ln_phase(xf, xb, nullptr, lng + 2 * DM, lnb + 2 * DM, c, G);
        xcd_barrier(xbar);
        { pg8::TileOrder S; S.init(NTOK, 2 * DFF, DM, G, c); pg8::Gemm g{xb, (const bf16_t*)(ws + W_GU), DM, DM}; pg8::EpiSwiGLU E{(bf16_t*)(ws + BIG_H)}; pg8::gemm_phase(lds, g, S, E); }
        xcd_barrier(xbar);
        { pg8::TileOrder S; S.init(NTOK, DM, DFF, G, c); pg8::Gemm g{(const bf16_t*)(ws + BIG_H), (const bf16_t*)(ws + W_DOWN), DFF, DFF}; pg8::EpiResid E{xf, 0.5f}; pg8::gemm_phase(lds, g, S, E); }
        xcd_barrier(xbar);
        ln_phase(xf, xb, l == DEPTH - 1 ? p.out : nullptr, lng + 3 * DM, lnb + 3 * DM, c, G);
        if (l + 1 < DEPTH) {
            cvt_matrix(p.in[IN_F1GU] + (size_t)(l + 1) * DM * 2 * DFF, DM, 2 * DFF, (bf16_t*)(ws + W_GU), 2 * DFF, MAP_GU, lds, c, G);
            cvt_matrix(p.in[IN_F1DN] + (size_t)(l + 1) * DFF * DM, DFF, DM, (bf16_t*)(ws + W_DOWN), DM, MAP_ID, lds, c, G);
            cvt_wmix(p, l + 1, lds, c, G);
        }
        xcd_barrier(xbar);
}

__global__ void __launch_bounds__(NTHREADS) mega(Params p) {
    extern __shared__ __attribute__((aligned(16))) unsigned char lds_raw[];
    LAS unsigned char* lds = (LAS unsigned char*)lds_raw;
    cg::grid_group grid = cg::this_grid();
    const int G = gridDim.x, c = blockIdx.x;
    if (threadIdx.x == 0) { LAS unsigned* z = (LAS unsigned*)(lds + L_XBST); z[0] = 0u; z[1] = 0u; z[2] = 0u; z[3] = 0u; }
    __syncthreads();
    const XcdBarrier xbar = xcd_barrier_post((unsigned*)(p.ws + S_BAR), (volatile LAS unsigned*)(lds + L_XBST));
    unsigned char* ws = p.ws;
    float* xf = (float*)(ws + WS_XF); bf16_t* xb = (bf16_t*)(ws + WS_XB);

    {
        const f32x4* xi = (const f32x4*)p.in[IN_X]; const int tid = otid();
        for (size_t i = (size_t)c * NTHREADS + tid; i < (size_t)NTOK * DM / 4; i += (size_t)G * NTHREADS) { const f32x4 v = xi[i]; ((f32x4*)xf)[i] = v; u32x2 w; w.x = pk2(v[0], v[1]); w.y = pk2(v[2], v[3]); ((u32x2*)xb)[i] = w; }
        cvt_matrix(p.in[IN_F1GU], DM, 2 * DFF, (bf16_t*)(ws + W_GU), 2 * DFF, MAP_GU, lds, c, G);
        cvt_matrix(p.in[IN_F1DN], DFF, DM, (bf16_t*)(ws + W_DOWN), DM, MAP_ID, lds, c, G);
        cvt_wmix(p, 0, lds, c, G);
        table_phase(ws, c, G);
        const f32x4* mi = (const f32x4*)p.in[IN_MEM]; bf16_t* memb = (bf16_t*)(ws + S_MEMB);
        for (size_t i = (size_t)c * NTHREADS + tid; i < (size_t)NB * NMEM * DM / 4; i += (size_t)G * NTHREADS) { const f32x4 v = mi[i]; u32x2 w; w.x = pk2(v[0], v[1]); w.y = pk2(v[2], v[3]); ((u32x2*)memb)[i] = w; }
    }
    grid.sync();
    layer_body<0>(p, xbar, lds, c, G);
    layer_body<1>(p, xbar, lds, c, G);
}

extern "C" void kernel_launch(void* const* d_in, const int* in_sizes, int n_in, void* d_out, int out_size, void* d_ws, size_t ws_size, hipStream_t stream) {
    static int grid = 0;
    if (grid == 0) {
        if (n_in != 23 || out_size != NTOK * DM || ws_size < WS_END) { fprintf(stderr, "kernel_launch: unexpected shapes (n_in %d out %d ws %zu need %zu)\n", n_in, out_size, ws_size, (size_t)WS_END); grid = -1; return; }
        int dev = 0, cus = 0, per_cu = 0;
        hipGetDevice(&dev); hipDeviceGetAttribute(&cus, hipDeviceAttributeMultiprocessorCount, dev);
        if (hipFuncSetAttribute((const void*)mega, hipFuncAttributeMaxDynamicSharedMemorySize, LDS_BYTES) != hipSuccess) { fprintf(stderr, "kernel_launch: hipFuncSetAttribute failed\n"); grid = -1; return; }
        if (hipOccupancyMaxActiveBlocksPerMultiprocessor(&per_cu, (const void*)mega, NTHREADS, LDS_BYTES) != hipSuccess || per_cu < 1) { fprintf(stderr, "kernel_launch: occupancy query says %d\n", per_cu); grid = -1; return; }
        grid = cus;
    }
    if (grid < 0) return;
    if (hipMemsetAsync((char*)d_ws + S_BAR, 0, XCD_BAR_WORDS * 4, stream) != hipSuccess) { fprintf(stderr, "kernel_launch: memset failed\n"); return; }
    Params p{};
    for (int i = 0; i < 23; ++i) p.in[i] = (const float*)d_in[i];
    p.out = (float*)d_out; p.ws = (unsigned char*)d_ws; p.phase_lo = 0; p.phase_hi = 1000;
    void* args[] = {&p};
    hipError_t e = hipLaunchCooperativeKernel((const void*)mega, dim3(grid), dim3(NTHREADS), args, LDS_BYTES, stream);
    if (e != hipSuccess) fprintf(stderr, "cooperative launch failed: %s (grid %d)\n", hipGetErrorString(e), grid);
}
```

```cpp
#include <hip/hip_runtime.h>
#include <hip/hip_cooperative_groups.h>
#include <cstdio>
#include <cstdint>
namespace cg = cooperative_groups;

#define DI __device__ __forceinline__
#define LAS __attribute__((address_space(3)))
typedef unsigned short bf16_t;
typedef short bf16x8 __attribute__((ext_vector_type(8)));
typedef float f32x4 __attribute__((ext_vector_type(4)));
typedef float f32x16 __attribute__((ext_vector_type(16)));
typedef unsigned u32x4 __attribute__((ext_vector_type(4)));
typedef unsigned u32x2 __attribute__((ext_vector_type(2)));

constexpr int DM = 1024, NB = 4, SEQ = 4096, NTOK = NB * SEQ, DEPTH = 2, NMEM = 256, DFF = 2816, DIN = 7224;
constexpr int PN = 3328;
constexpr float ALPHA = 1.4142135623730951f;
constexpr float LN_EPS = 1e-5f;
constexpr int C_RQ = 0, C_RK = 128, C_RV = 256, C_RG = 512, C_DQ = 768, C_DK = 1024, C_DV = 1088, C_IQ = 1152, C_IK = 1408,
              C_NQ = 1440, C_NKC = 1696, C_NVC = 1760, C_NKS = 1824, C_NVS = 1888, C_NKW = 1952, C_NVW = 2016,
              C_SZ = 2080, C_SX = 2336, C_SB = 2592, C_SC = 2848, C_IW = 3104, C_NG = 3112, C_SDT = 3124;

constexpr int NTHREADS = 512, NWAVES = 8;
constexpr int LDS_BYTES = 160 * 1024;

constexpr size_t MiB = 1024 * 1024;
constexpr size_t WS_XF = 0;
constexpr size_t WS_XB = 64 * MiB;
constexpr size_t WS_YS = 96 * MiB;
constexpr size_t WS_BIG = 128 * MiB;
constexpr size_t WS_SLOTF = 232 * MiB;
constexpr size_t WS_WMIX = WS_SLOTF + 16 * MiB + 512 * 1024;
constexpr size_t WS_SMALL = WS_WMIX + 27 * MiB + 512 * 1024;
constexpr size_t WS_BITS = WS_SMALL + 8 * MiB;
constexpr size_t WS_KF = WS_BITS + 8 * MiB;
constexpr size_t KF_DK = WS_KF, KF_NKS = WS_KF + 2 * MiB, KF_NKW = WS_KF + 4 * MiB, KF_IK = WS_KF + 6 * MiB;
constexpr size_t WS_END = WS_KF + 7 * MiB;
constexpr size_t BIG_H = WS_BIG, BIG_PROJ = WS_BIG, BIG_GBUF = WS_BIG, BIG_MERGED = WS_BIG + 32 * MiB, BIG_QX = WS_BIG, BIG_AO = WS_BIG + 32 * MiB;
constexpr size_t W_GU = WS_SLOTF, W_DOWN = WS_SLOTF + 11 * MiB;
constexpr size_t W_IN = WS_WMIX, W_G = W_IN + (size_t)PN * 1024 * 2, W_B = W_G + 8 * MiB, W_OUT = W_B + 2 * MiB, W_Q = W_OUT + 2 * MiB,
                 W_KV = W_Q + 2 * MiB, W_O = W_KV + 4 * MiB, W_C1 = W_O + 2 * MiB, W_C2 = W_C1 + 512 * 1024, W_MIX_END = W_C2 + 16 * 1024;
static_assert(W_MIX_END <= WS_SMALL, "wmix overflow");
constexpr size_t S_MEMB = WS_SMALL, S_KVX = S_MEMB + 2 * MiB, S_TAB = S_KVX + 4 * MiB;

enum { IN_X = 0, IN_MEM, IN_LNG, IN_LNB, IN_F1GU, IN_F1DN, IN_WIN, IN_C1, IN_C2, IN_CPOS, IN_CONVW, IN_CONVB, IN_DTB, IN_ALOG, IN_DSKIP, IN_SNG,
       IN_WBR, IN_WOUT, IN_XQ, IN_XKV, IN_XO, IN_F2GU, IN_F2DN };

struct Params {
    const float* in[23];
    float* out;
    unsigned char* ws;
    int phase_lo, phase_hi;
};

DI float bf2f(bf16_t b) { return __uint_as_float(((unsigned)b) << 16); }
DI bf16_t f2bf(float f) { unsigned u = __float_as_uint(f); u += 0x7fffu + ((u >> 16) & 1u); return (bf16_t)(u >> 16); }
DI unsigned pk2(float lo, float hi) { unsigned r; asm volatile("v_cvt_pk_bf16_f32 %0, %1, %2" : "=v"(r) : "v"(lo), "v"(hi)); return r; }
DI float wave_sum(float v) {
#pragma unroll
    for (int o = 1; o < 64; o <<= 1) v += __shfl_xor(v, o);
    return v;
}
DI int launder(int t) { asm volatile("" : "+v"(t)); return t; }
DI int otid() { int t = threadIdx.x; asm volatile("" : "+v"(t)); return t; }
DI float sigmoidf_(float x) { return 1.0f / (1.0f + __expf(-x)); }
DI float siluf_(float x) { return x / (1.0f + __expf(-x)); }


#define XB_TMO      128
#define XB_XCNT(j)  (256  + 64 * (j))
#define XB_XSUB(j)  (1280 + 64 * (j))
#define XB_XGEN(j)  (2304 + 64 * (j))
#define XB_TOP      3328
#define XB_TOPGEN   3392
#define XCD_BAR_WORDS 3456
#define XB_SPIN_CAP (1u << 18)
DI unsigned xb_ld(unsigned* p) { return __hip_atomic_load(p, __ATOMIC_RELAXED, __HIP_MEMORY_SCOPE_AGENT); }
DI unsigned xb_add(unsigned* p, unsigned v) { return __hip_atomic_fetch_add(p, v, __ATOMIC_RELAXED, __HIP_MEMORY_SCOPE_AGENT); }
DI unsigned xb_xcc_id() { return (unsigned)__builtin_amdgcn_s_getreg((3 << 11) | 20) & 0xFu; }
#define XB_SPIN(cond, bar) do { unsigned _sp = 0; while (cond) { __builtin_amdgcn_s_sleep(1); \
    if ((++_sp & 255u) == 0u) { if (xb_ld(&(bar)[XB_TMO])) break; if (_sp > XB_SPIN_CAP) { atomicAdd(&(bar)[XB_TMO], 1u); break; } } } } while (0)
struct XcdBarrier { unsigned* bar; unsigned x; volatile LAS unsigned* st; };
DI XcdBarrier xcd_barrier_post(unsigned* bar, volatile LAS unsigned* st) {
    XcdBarrier b; b.bar = bar; b.x = xb_xcc_id(); b.st = st;
    if (threadIdx.x == 0) (void)xb_add(&bar[XB_XCNT(b.x)], 1u);
    return b;
}
DI void xcd_barrier_complete(unsigned* bar, unsigned x, unsigned& nloc, unsigned& nx) {
    const unsigned G = gridDim.x * gridDim.y * gridDim.z;
    unsigned sum, cnt, mine, sp = 0u;
    for (;;) {
        sum = 0u; cnt = 0u; mine = 0u;
#pragma unroll
        for (unsigned j = 0; j < 16; ++j) { const unsigned c = xb_ld(&bar[XB_XCNT(j)]); sum += c; cnt += (c > 0u) ? 1u : 0u; mine = (j == x) ? c : mine; }
        if (sum == G) break;
        __builtin_amdgcn_s_sleep(1);
        if ((++sp & 255u) == 0u) { if (xb_ld(&bar[XB_TMO])) break; if (sp > XB_SPIN_CAP) { atomicAdd(&bar[XB_TMO], 1u); break; } }
    }
    nloc = mine > 0u ? mine : 1u; nx = cnt > 0u ? cnt : 1u;
}
DI void xcd_barrier(const XcdBarrier& b) {
    asm volatile("s_waitcnt vmcnt(0)" ::: "memory");
    __syncthreads();
    if (threadIdx.x == 0) {
        unsigned* bar = b.bar;
        __builtin_amdgcn_s_waitcnt(0);
        unsigned nloc = b.st[0], nx = b.st[1];
        if (nloc == 0u) { xcd_barrier_complete(bar, b.x, nloc, nx); b.st[0] = nloc; b.st[1] = nx; }
        const unsigned old = xb_add(&bar[XB_XSUB(b.x)], 1u);
        const unsigned gen = old / nloc;
        if (old + 1u == (gen + 1u) * nloc) {
            __builtin_amdgcn_fence(__ATOMIC_RELEASE, "agent");
            asm volatile("s_waitcnt vmcnt(0)" ::: "memory");
            const unsigned og = xb_add(&bar[XB_TOP], 1u);
            const unsigned tg = og / nx;
            if (og + 1u == (tg + 1u) * nx) xb_add(&bar[XB_TOPGEN], 1u);
            else XB_SPIN(xb_ld(&bar[XB_TOPGEN]) == tg, bar);
            __builtin_amdgcn_fence(__ATOMIC_ACQUIRE, "agent");
            xb_add(&bar[XB_XGEN(b.x)], 1u);
            asm volatile("s_waitcnt vmcnt(0)" ::: "memory");
        } else {
            XB_SPIN(xb_ld(&bar[XB_XGEN(b.x)]) == gen, bar);
            __builtin_amdgcn_fence(__ATOMIC_ACQUIRE, "agent");
            asm volatile("s_waitcnt vmcnt(0)" ::: "memory");
        }
    }
    __syncthreads();
}
constexpr int L_XBST = 163840 - 64;

namespace pg8 {
constexpr int BM = 256, BK = 64, HALF = 128, HTB = HALF * BK * 2, STAGE_BYTES = 8 * HTB, NXCD = 8, WGM = 8;
DI int lds_byte(int r, int c) { const int st = (r >> 4) * 2 + (c >> 5), rr = r & 15, cc = c & 31, ob = rr * 64 + cc * 2; return st * 1024 + (ob ^ (((ob >> 9) & 1) << 5)); }
DI void stage_rc(int b, int& R, int& C) { const int st = b / 1024, sb = b % 1024, swz = sb ^ (((sb >> 9) & 1) << 5); R = (st >> 1) * 16 + swz / 64; C = (st & 1) * 32 + (swz % 64) / 2; }
DI int perm32(int rho) { const int n = rho >> 4, i = rho & 15; return 8 * (i >> 2) + 4 * n + (i & 3); }

struct Unit { int pm, pn; long aoff, boff; int nt, aux; };
struct Gemm { const bf16_t* A; const bf16_t* Bt; int lda, ldb; };

struct TileOrder {
    int nM, nN, nwg, G, c, nt;
    DI void init(int M, int N, int K, int G_, int c_) { nM = M / BM; nN = N / BM; nwg = nM * nN; G = G_; c = c_; nt = K / BK; }
    DI bool next(int i, Unit& u) const {
        const long L = (long)i * G + c; if (L >= nwg) return false;
        int wgid = (int)L; { const int q = nwg / NXCD, r = nwg % NXCD, xcd = wgid % NXCD, off = wgid / NXCD; wgid = (xcd < r ? xcd * (q + 1) : r * (q + 1) + (xcd - r) * q) + off; }
        const int nig = WGM * nN, gid = wgid / nig, fm = gid * WGM, gsz = (nM - fm) < WGM ? (nM - fm) : WGM;
        u.pm = fm + ((wgid % nig) % gsz); u.pn = (wgid % nig) / gsz; u.aoff = 0; u.boff = 0; u.nt = nt; u.aux = 0; return true;
    }
};

template <class Epi, class Sched>
DI void gemm_phase(LAS unsigned char* lds, const Gemm g, const Sched& S, const Epi& E) {
    const int tid = threadIdx.x, wid = __builtin_amdgcn_readfirstlane(tid >> 6), lane = tid & 63, wr = wid >> 2, wc = wid & 3, fr = lane & 15, fq = lane >> 4;
    unsigned voffA[2], voffB[2];
#pragma unroll
    for (int i = 0; i < 2; ++i) { int R, C; stage_rc(tid * 16 + i * 8192, R, C); const int Rb = Epi::PERM ? ((R & ~31) + perm32(R & 31)) : R;
        voffA[i] = (unsigned)(R * g.lda + C) * 2u; voffB[i] = (unsigned)(Rb * g.ldb + C) * 2u; }
    const size_t kstep = (size_t)(BK * 2);
    const size_t hstepA = (size_t)HALF * g.lda * 2, hstepB = (size_t)HALF * g.ldb * 2;
    const size_t tstepA = 2 * hstepA, tstepB = 2 * hstepB;
    const unsigned ldsw = (unsigned)wid * 1024u;
    const int aoff = lds_byte(wr * 64 + fr, fq * 8), boff = lds_byte(wc * 32 + fr, fq * 8);
#define PG8_SA(b, h) (((b) * 2 + (h)) * HTB)
#define PG8_SB(b, h) ((4 + (b) * 2 + (h)) * HTB)
#define PG8_STAGE(bufoff, gbase, voff) do { _Pragma("unroll") for (int _i = 0; _i < 2; ++_i) \
        __builtin_amdgcn_global_load_lds((const unsigned*)((const char*)(gbase) + (voff)[_i]), (LAS unsigned*)(lds + (bufoff) + ldsw + _i * 8192), 16, 0, 0); } while (0)
#define PG8_LDA(dst, b, h) do { _Pragma("unroll") for (int m = 0; m < 4; ++m) _Pragma("unroll") for (int k = 0; k < 2; ++k) dst[m][k] = *(const LAS bf16x8*)(lds + PG8_SA(b, h) + aoff + m * 2048 + k * 1024); } while (0)
#define PG8_LDB(dst, b, h) do { _Pragma("unroll") for (int n = 0; n < 2; ++n) _Pragma("unroll") for (int k = 0; k < 2; ++k) dst[n][k] = *(const LAS bf16x8*)(lds + PG8_SB(b, h) + boff + n * 2048 + k * 1024); } while (0)
#define PG8_MMA(ai, bj, At, Bt) do { __builtin_amdgcn_s_setprio(1); _Pragma("unroll") for (int m = 0; m < 4; ++m) _Pragma("unroll") for (int n = 0; n < 2; ++n) _Pragma("unroll") for (int k = 0; k < 2; ++k) \
        acc[ai][bj][m][n] = __builtin_amdgcn_mfma_f32_16x16x32_bf16(Bt[n][k], At[m][k], acc[ai][bj][m][n], 0, 0, 0); __builtin_amdgcn_s_setprio(0); } while (0)
#define PG8_WAIT_V(n) asm volatile("s_waitcnt vmcnt(" #n ")" ::: "memory")
#define PG8_WAIT_L(n) asm volatile("s_waitcnt lgkmcnt(" #n ")" ::: "memory")
#define PG8_BAR __builtin_amdgcn_s_barrier()
#define PG8_SCHED __builtin_amdgcn_sched_barrier(0)
    Unit cur, nxt; int ui = 0;
    if (!S.next(0, cur)) return;
    f32x4 acc[2][2][4][2];
#pragma unroll
    for (int a = 0; a < 2; ++a)
#pragma unroll
        for (int b = 0; b < 2; ++b)
#pragma unroll
            for (int m = 0; m < 4; ++m)
#pragma unroll
                for (int n = 0; n < 2; ++n) acc[a][b][m][n] = (f32x4){0.f, 0.f, 0.f, 0.f};
    bf16x8 At[4][2], B0[2][2], B1[2][2];
    const char* cA = (const char*)g.A + (size_t)cur.pm * tstepA + cur.aoff; const char* cB = (const char*)g.Bt + (size_t)cur.pn * tstepB + cur.boff;
    PG8_STAGE(PG8_SB(0, 0), cB, voffB); PG8_STAGE(PG8_SA(0, 0), cA, voffA); PG8_STAGE(PG8_SB(0, 1), cB + hstepB, voffB); PG8_STAGE(PG8_SA(0, 1), cA + hstepA, voffA);
    if (wr == 1) PG8_BAR;
    PG8_WAIT_V(4); PG8_BAR;
    PG8_STAGE(PG8_SB(1, 0), cB + kstep, voffB); PG8_STAGE(PG8_SA(1, 0), cA + kstep, voffA); PG8_STAGE(PG8_SB(1, 1), cB + hstepB + kstep, voffB);
    PG8_WAIT_V(6); PG8_BAR;
    for (;;) {
        const bool has_next = S.next(ui + 1, nxt);
        const char* nA = has_next ? (const char*)g.A + (size_t)nxt.pm * tstepA + nxt.aoff : cA; const char* nB = has_next ? (const char*)g.Bt + (size_t)nxt.pn * tstepB + nxt.boff : cB;
        const int nt = cur.nt;
        for (int t = 0; t < nt; t += 2) {
            const bool last = (t == nt - 2);
            const char* a1 = cA + (size_t)(t + 1) * kstep;
            const char* a2 = last ? nA : cA + (size_t)(t + 2) * kstep; const char* b2 = last ? nB : cB + (size_t)(t + 2) * kstep;
            const char* a3 = a2 + kstep; const char* b3 = b2 + kstep;
            PG8_LDB(B0, 0, 0); PG8_SCHED; PG8_LDA(At, 0, 0); PG8_STAGE(PG8_SA(1, 1), a1 + hstepA, voffA);
            PG8_WAIT_L(8); PG8_BAR; PG8_WAIT_L(0); PG8_MMA(0, 0, At, B0); PG8_BAR; PG8_SCHED;
            PG8_LDB(B1, 0, 1); PG8_STAGE(PG8_SB(0, 0), b2, voffB);
            PG8_BAR; PG8_WAIT_L(0); PG8_MMA(0, 1, At, B1); PG8_BAR;
            PG8_LDA(At, 0, 1); PG8_STAGE(PG8_SA(0, 0), a2, voffA);
            PG8_BAR; PG8_WAIT_L(0); PG8_MMA(1, 0, At, B0); PG8_BAR; PG8_SCHED;
            PG8_STAGE(PG8_SB(0, 1), b2 + hstepB, voffB);
            PG8_WAIT_V(6); PG8_BAR; PG8_MMA(1, 1, At, B1); PG8_BAR;
            PG8_LDB(B0, 1, 0); PG8_SCHED; PG8_LDA(At, 1, 0); PG8_STAGE(PG8_SA(0, 1), a2 + hstepA, voffA);
            PG8_WAIT_L(8); PG8_BAR; PG8_WAIT_L(0); PG8_MMA(0, 0, At, B0); PG8_BAR; PG8_SCHED;
            PG8_LDB(B1, 1, 1); PG8_STAGE(PG8_SB(1, 0), b3, voffB);
            PG8_BAR; PG8_WAIT_L(0); PG8_MMA(0, 1, At, B1); PG8_BAR;
            PG8_LDA(At, 1, 1); PG8_STAGE(PG8_SA(1, 0), a3, voffA);
            PG8_BAR; PG8_WAIT_L(0); PG8_MMA(1, 0, At, B0); PG8_BAR; PG8_SCHED;
            PG8_STAGE(PG8_SB(1, 1), b3 + hstepB, voffB);
            PG8_WAIT_V(6); PG8_BAR; PG8_MMA(1, 1, At, B1); PG8_BAR;
        }
        E(acc, cur, wr, wc, fr, fq);
        if (!has_next) break;
#pragma unroll
        for (int a = 0; a < 2; ++a)
#pragma unroll
            for (int b = 0; b < 2; ++b)
#pragma unroll
                for (int m = 0; m < 4; ++m)
#pragma unroll
                    for (int n = 0; n < 2; ++n) acc[a][b][m][n] = (f32x4){0.f, 0.f, 0.f, 0.f};
        cur = nxt; cA = nA; cB = nB; ++ui;
    }
    PG8_WAIT_V(0);
    if (wr == 0) PG8_BAR;
    PG8_BAR;
#undef PG8_SA
#undef PG8_SB
#undef PG8_STAGE
#undef PG8_LDA
#undef PG8_LDB
#undef PG8_MMA
#undef PG8_WAIT_V
#undef PG8_WAIT_L
#undef PG8_BAR
#undef PG8_SCHED
}

struct EpiSwiGLU {
    static constexpr bool PERM = false;
    bf16_t* H;
    DI void operator()(const f32x4 (&acc)[2][2][4][2], const Unit& u, int wr, int wc, int fr, int fq) const {
        const int row0 = u.pm * BM + wr * 64 + fr, hc0 = u.pn * 128 + wc * 16 + fq * 4;
#pragma unroll
        for (int ai = 0; ai < 2; ++ai)
#pragma unroll
            for (int m = 0; m < 4; ++m) { bf16_t* rowp = H + (size_t)(row0 + ai * HALF + m * 16) * DFF + hc0;
#pragma unroll
                for (int bj = 0; bj < 2; ++bj) { const f32x4 gg = acc[ai][bj][m][0], uu = acc[ai][bj][m][1];
                    u32x2 w; w.x = pk2(siluf_(gg[0]) * uu[0], siluf_(gg[1]) * uu[1]); w.y = pk2(siluf_(gg[2]) * uu[2], siluf_(gg[3]) * uu[3]);
                    *(u32x2*)(rowp + bj * 64) = w; } }
    }
};
struct EpiResid {
    static constexpr bool PERM = false;
    float* X; float s;
    DI void operator()(const f32x4 (&acc)[2][2][4][2], const Unit& u, int wr, int wc, int fr, int fq) const {
        const int row0 = u.pm * BM + wr * 64 + fr, col0 = u.pn * BM + wc * 32 + 4 * fq;
#pragma unroll
        for (int ai = 0; ai < 2; ++ai)
#pragma unroll
            for (int m = 0; m < 4; ++m) { float* rowp = X + (size_t)(row0 + ai * HALF + m * 16) * DM + col0;
#pragma unroll
                for (int bj = 0; bj < 2; ++bj)
#pragma unroll
                    for (int n = 0; n < 2; ++n) { f32x4* p = (f32x4*)(rowp + bj * HALF + n * 16); const f32x4 o = *p; *p = o * ALPHA + acc[ai][bj][m][n] * s; } }
    }
};
struct EpiBf16 {
    static constexpr bool PERM = true;
    bf16_t* O; int ldc;
    DI void operator()(const f32x4 (&acc)[2][2][4][2], const Unit& u, int wr, int wc, int fr, int fq) const {
        const int row0 = u.pm * BM + wr * 64 + fr, col0 = u.pn * BM + wc * 32 + 8 * fq;
#pragma unroll
        for (int ai = 0; ai < 2; ++ai)
#pragma unroll
            for (int m = 0; m < 4; ++m) { bf16_t* rowp = O + (size_t)(row0 + ai * HALF + m * 16) * ldc + col0;
#pragma unroll
                for (int bj = 0; bj < 2; ++bj) { const f32x4 v0 = acc[ai][bj][m][0], v1 = acc[ai][bj][m][1];
                    u32x4 w; w.x = pk2(v0[0], v0[1]); w.y = pk2(v0[2], v0[3]); w.z = pk2(v1[0], v1[1]); w.w = pk2(v1[2], v1[3]);
                    *(u32x4*)(rowp + bj * HALF) = w; } }
    }
};
}

enum { MAP_ID = 0, MAP_GU = 1, MAP_IN = 2, MAP_GATE = 3 };
DI int map_col(int kind, int r) {
    if (kind == MAP_GU) { const int pn = r >> 8, c = r & 255; const int bj = c >> 7, wc = (c >> 5) & 3, n = (c >> 4) & 1, fq = (c >> 2) & 3, j = c & 3; return n * DFF + pn * 128 + bj * 64 + wc * 16 + fq * 4 + j; }
    if (kind == MAP_IN) {
        if (r < 1440) return r;
        if (r < 2080) return r + 8;
        if (r < 3104) return r + 20;
        if (r < 3112) return r - 3104 + 1440;
        if (r < 3124) return r - 3112 + 2088;
        if (r < 3128) return r;
        return -1;
    }
    if (kind == MAP_GATE) return 3128 + r;
    return r;
}
DI void cvt_item(const float* W, int K, int N, bf16_t* WT, int kind, LAS float* scr, int item, int nblk, int lane) {
    const int kb = item / nblk, nb = item % nblk, k0 = 64 * kb, n0 = 32 * nb;
    const int sc = map_col(kind, n0 + (lane & 31));
#pragma unroll 8
    for (int i = 0; i < 32; ++i) { const int kk = 2 * i + (lane >> 5); scr[kk * 33 + (lane & 31)] = sc >= 0 ? W[(size_t)(k0 + kk) * N + sc] : 0.f; }
    asm volatile("s_waitcnt lgkmcnt(0)" ::: "memory");
    const int c = lane & 7;
#pragma unroll
    for (int j = 0; j < 4; ++j) { const int n = (lane >> 3) + 8 * j; const LAS float* s = scr + (8 * c) * 33 + n;
        u32x4 o; o.x = pk2(s[0 * 33], s[1 * 33]); o.y = pk2(s[2 * 33], s[3 * 33]); o.z = pk2(s[4 * 33], s[5 * 33]); o.w = pk2(s[6 * 33], s[7 * 33]);
        *(u32x4*)(WT + (size_t)(n0 + n) * K + k0 + 8 * c) = o; }
    asm volatile("s_waitcnt lgkmcnt(0)" ::: "memory");
}
DI void cvt_matrix(const float* W, int K, int N, bf16_t* WT, int rows, int kind, LAS unsigned char* lds, int c, int G) {
    const int tid = otid(), wave = tid >> 6, gw = c * NWAVES + wave, ngw = G * NWAVES;
    LAS float* scr = (LAS float*)(lds + wave * 16384);
    const int nblk = rows / 32, nitems = (K / 64) * nblk, lane = tid & 63;
    for (int it = gw; it < nitems; it += ngw) cvt_item(W, K, N, WT, kind, scr, it, nblk, lane);
}

DI void ln_phase(float* X, bf16_t* XB, float* OUT, const float* g, const float* b, int c, int G) {
    const int tid = otid(), lane = tid & 63, gw = c * NWAVES + (tid >> 6), ngw = G * NWAVES;
    f32x4 gv[4], bv[4];
#pragma unroll
    for (int j = 0; j < 4; ++j) { gv[j] = ((const f32x4*)g)[lane + 64 * j]; bv[j] = ((const f32x4*)b)[lane + 64 * j]; }
    for (int row = gw; row < NTOK; row += ngw) {
        f32x4* xr = (f32x4*)(X + (size_t)row * DM) + lane;
        f32x4 v[4]; float s = 0.f;
#pragma unroll
        for (int j = 0; j < 4; ++j) { v[j] = xr[64 * j]; s += (v[j][0] + v[j][1]) + (v[j][2] + v[j][3]); }
        const float mean = wave_sum(s) * (1.f / DM); float s2 = 0.f;
#pragma unroll
        for (int j = 0; j < 4; ++j) { v[j] = v[j] - mean; s2 += (v[j][0] * v[j][0] + v[j][1] * v[j][1]) + (v[j][2] * v[j][2] + v[j][3] * v[j][3]); }
        const float rstd = 1.0f / sqrtf(wave_sum(s2) * (1.f / DM) + LN_EPS);
        float* orow = OUT ? OUT + (size_t)row * DM : X + (size_t)row * DM;
#pragma unroll
        for (int j = 0; j < 4; ++j) { const f32x4 o = v[j] * rstd * gv[j] + bv[j]; ((f32x4*)orow)[lane + 64 * j] = o;
            if (XB) { u32x2 w; w.x = pk2(o[0], o[1]); w.y = pk2(o[2], o[3]); ((u32x2*)(XB + (size_t)row * DM))[lane + 64 * j] = w; } }
    }
}


struct EpiKV {
    static constexpr bool PERM = true;
    bf16_t* KX; bf16_t* VT;
    DI void operator()(const f32x4 (&acc)[2][2][4][2], const pg8::Unit& u, int wr, int wc, int fr, int fq) const {
        const int row0 = wr * 64 + fr, col0 = u.pn * 256 + wc * 32 + 8 * fq;
#pragma unroll
        for (int ai = 0; ai < 2; ++ai)
#pragma unroll
            for (int m = 0; m < 4; ++m) { const int mr = row0 + ai * 128 + m * 16;
#pragma unroll
                for (int bj = 0; bj < 2; ++bj) { const f32x4 v0 = acc[ai][bj][m][0], v1 = acc[ai][bj][m][1]; const int col = col0 + bj * 128;
                    if (u.pn < 4) { u32x4 w; w.x = pk2(v0[0], v0[1]); w.y = pk2(v0[2], v0[3]); w.z = pk2(v1[0], v1[1]); w.w = pk2(v1[2], v1[3]);
                        *(u32x4*)(KX + (size_t)(u.pm * 256 + mr) * DM + col) = w; }
                    else { bf16_t* vp = VT + ((size_t)u.pm * DM + (col - DM)) * NMEM + mr;
#pragma unroll
                        for (int e = 0; e < 4; ++e) { vp[(size_t)e * NMEM] = f2bf(v0[e]); vp[(size_t)(e + 4) * NMEM] = f2bf(v1[e]); } } } }
    }
};
#define MFMA32(a, b, c) __builtin_amdgcn_mfma_f32_32x32x16_bf16((a), (b), (c), 0, 0, 0)
DI float half_max(float v) {
#pragma unroll
    for (int o = 1; o < 32; o <<= 1) v = fmaxf(v, __shfl_xor(v, o));
    return v;
}
DI float half_sum(float v) {
#pragma unroll
    for (int o = 1; o < 32; o <<= 1) v += __shfl_xor(v, o);
    return v;
}
DI int crow(int r, int hh) { return 8 * (r >> 2) + 4 * hh + (r & 3); }
DI void xattn_phase(const bf16_t* qx, const bf16_t* kx, const bf16_t* vT, bf16_t* ao, LAS unsigned char* lds, int c, int G) {
    const int tid = otid(), lane = tid & 63, wave = tid >> 6, r32 = lane & 31, hh = lane >> 5;
    LAS bf16_t* P = (LAS bf16_t*)(lds + wave * (32 * 264 * 2));
    for (int item = c * NWAVES + wave; item < 2048; item += G * NWAVES) {
        const int b = item >> 9, h = (item >> 7) & 3, t0 = (item & 127) * 32;
        const bf16_t* qrow = qx + (size_t)(b * SEQ + t0 + r32) * DM + h * 256 + hh * 8;
        const bf16_t* krow = kx + (size_t)(b * NMEM + r32) * DM + h * 256 + hh * 8;
        f32x16 S[8];
#pragma unroll
        for (int j = 0; j < 8; ++j)
#pragma unroll
            for (int r = 0; r < 16; ++r) S[j][r] = 0.f;
#pragma unroll 2
        for (int ks = 0; ks < 16; ++ks) {
            const bf16x8 a = *(const bf16x8*)(qrow + ks * 16);
#pragma unroll
            for (int j = 0; j < 8; ++j) { const bf16x8 bb = *(const bf16x8*)(krow + (size_t)j * 32 * DM + ks * 16); S[j] = MFMA32(a, bb, S[j]); }
        }
        float inv[16];
#pragma unroll
        for (int r = 0; r < 16; ++r) {
            float m = S[0][r];
#pragma unroll
            for (int j = 1; j < 8; ++j) m = fmaxf(m, S[j][r]);
            m = half_max(m);
            float sm = 0.f;
#pragma unroll
            for (int j = 0; j < 8; ++j) { const float e = __expf((S[j][r] - m) * 0.0625f); sm += e; P[crow(r, hh) * 264 + j * 32 + r32] = f2bf(e); }
            inv[r] = 1.0f / half_sum(sm);
        }
        const bf16_t* vrow = vT + ((size_t)b * DM + h * 256 + r32) * NMEM + hh * 8;
        bf16_t* orow = ao + (size_t)(b * SEQ + t0) * DM + h * 256 + r32;
#pragma unroll 1
        for (int half = 0; half < 2; ++half) {
            f32x16 O[4];
#pragma unroll
            for (int j = 0; j < 4; ++j)
#pragma unroll
                for (int r = 0; r < 16; ++r) O[j][r] = 0.f;
#pragma unroll 2
            for (int ks = 0; ks < 16; ++ks) {
                const bf16x8 a = *(const LAS bf16x8*)(P + r32 * 264 + ks * 16 + hh * 8);
#pragma unroll
                for (int j = 0; j < 4; ++j) { const bf16x8 bb = *(const bf16x8*)(vrow + (size_t)(half * 4 + j) * 32 * NMEM + ks * 16); O[j] = MFMA32(a, bb, O[j]); }
            }
#pragma unroll
            for (int r = 0; r < 16; ++r)
#pragma unroll
                for (int j = 0; j < 4; ++j) orow[(size_t)crow(r, hh) * DM + (half * 4 + j) * 32] = f2bf(O[j][r] * inv[r]);
        }
    }
}

constexpr size_t X_DVT = WS_SLOTF, X_NVST = X_DVT + 2 * MiB, X_NVWT = X_NVST + 2 * MiB;
constexpr size_t X_RST = X_NVWT + 2 * MiB;
constexpr size_t X_SST = X_RST + 2 * MiB;
constexpr size_t X_CDEC = X_SST + 8 * MiB;
constexpr size_t X_END = X_CDEC + 4096;
static_assert(X_END <= WS_WMIX, "mixer scratch overflow");
constexpr size_t S_KCMP = S_TAB + 1 * MiB, S_VCMPT = S_KCMP + 128 * 1024, S_BAR = S_VCMPT + 128 * 1024;
constexpr size_t T_RC = S_TAB, T_RS = T_RC + 4096 * 16 * 4, T_AC = T_RS + 4096 * 16 * 4, T_AS = T_AC + 4096 * 8 * 4, T_IC = T_AS + 4096 * 8 * 4, T_IS = T_IC + 4096 * 4 * 4;
static_assert(T_IS + 4096 * 4 * 4 <= S_KCMP && S_BAR + 16384 <= WS_END, "small overflow");

DI void table_phase(unsigned char* ws, int c, int G) {
    const int tid = otid();
    for (int i = c * NTHREADS + tid; i < 4096 * 28; i += G * NTHREADS) {
        const int pos = i / 28, k = i % 28; double theta; int idx, rot; float *cp, *sp;
        if (k < 16) { theta = 10000.0; idx = k; rot = 32; cp = (float*)(ws + T_RC) + pos * 16 + idx; sp = (float*)(ws + T_RS) + pos * 16 + idx; }
        else if (k < 24) { theta = 500000.0; idx = k - 16; rot = 16; cp = (float*)(ws + T_AC) + pos * 8 + idx; sp = (float*)(ws + T_AS) + pos * 8 + idx; }
        else { theta = 500000.0; idx = k - 24; rot = 8; cp = (float*)(ws + T_IC) + pos * 4 + idx; sp = (float*)(ws + T_IS) + pos * 4 + idx; }
        const float inv = (float)exp2(-2.0 * idx / rot * log2(theta));
        const float ang = (float)pos * inv;
        double rev = (double)ang * 0.15915494309189533577; rev -= rint(rev);
        const float rf = (float)rev;
        *cp = __builtin_amdgcn_cosf(rf); *sp = __builtin_amdgcn_sinf(rf);
    }
}

DI void rope_pair(bf16_t* row, int c1, int c2, float cs, float sn, float scale) {
    const float x1 = bf2f(row[c1]), x2 = bf2f(row[c2]);
    row[c1] = f2bf((x1 * cs - x2 * sn) * scale); row[c2] = f2bf((x2 * cs + x1 * sn) * scale);
}
DI void prep_phase(unsigned char* ws, LAS unsigned char* lds, int c, int G) {
    const int tid = otid();
    bf16_t* proj = (bf16_t*)(ws + BIG_PROJ);
    const float *trc = (const float*)(ws + T_RC), *trs = (const float*)(ws + T_RS), *tac = (const float*)(ws + T_AC), *tas = (const float*)(ws + T_AS), *tic = (const float*)(ws + T_IC), *tis = (const float*)(ws + T_IS);
    LAS bf16_t* tile = (LAS bf16_t*)lds;
    for (int it = c; it < NTOK / 64; it += G) {
        const int tok0 = it * 64, b = tok0 / SEQ, p0 = tok0 % SEQ;
        for (int idx = tid; idx < 64 * 260; idx += NTHREADS) {
            const int tl = idx / 260, pr = idx % 260, pos = p0 + tl; bf16_t* row = proj + (size_t)(tok0 + tl) * PN;
            if (pr < 128) { const int q = pr & 63, hd = q >> 4, i = q & 15, base = (pr < 64 ? C_RQ : C_RK) + hd * 32 + i; rope_pair(row, base, base + 16, trc[pos * 16 + i], trs[pos * 16 + i], pr < 64 ? 1.0f : 0.17677669529663687f); }
            else if (pr < 160) { const int q = pr - 128, hd = q >> 3, i = q & 7, base = C_DQ + hd * 64 + i; rope_pair(row, base, base + 8, tac[pos * 8 + i], tas[pos * 8 + i], 1.0f); }
            else if (pr < 168) { const int i = pr - 160, base = C_DK + i; rope_pair(row, base, base + 8, tac[pos * 8 + i], tas[pos * 8 + i], 1.0f); }
            else if (pr < 200) { const int q = pr - 168, hd = q >> 2, i = q & 3, base = C_IQ + hd * 32 + i; rope_pair(row, base, base + 4, tic[pos * 4 + i], tis[pos * 4 + i], 1.0f); }
            else if (pr < 204) { const int i = pr - 200, base = C_IK + i; rope_pair(row, base, base + 4, tic[pos * 4 + i], tis[pos * 4 + i], 1.0f); }
            else if (pr < 236) { const int q = pr - 204, hd = q >> 3, i = q & 7, base = C_NQ + hd * 64 + i; rope_pair(row, base, base + 8, tac[pos * 8 + i], tas[pos * 8 + i], 1.0f); }
            else { const int q = pr - 236, w = q >> 3, i = q & 7, base = (w == 0 ? C_NKC : (w == 1 ? C_NKS : C_NKW)) + i; rope_pair(row, base, base + 8, tac[pos * 8 + i], tas[pos * 8 + i], 1.0f); }
        }
        for (int m = 0; m < 3; ++m) {
            const int col = m == 0 ? C_DV : (m == 1 ? C_NVS : C_NVW); bf16_t* vT = (bf16_t*)(ws + (m == 0 ? X_DVT : (m == 1 ? X_NVST : X_NVWT)));
            __syncthreads();
            { const int tl = tid >> 3, ch = tid & 7; const u32x4 v = *(const u32x4*)(proj + (size_t)(tok0 + tl) * PN + col + ch * 8);
              LAS unsigned* d = (LAS unsigned*)(tile + tl * 66 + ch * 8); d[0] = v.x; d[1] = v.y; d[2] = v.z; d[3] = v.w; }
            __syncthreads();
            { const int d = tid >> 3, grp = tid & 7, tt = grp >> 2, sk = (grp >> 1) & 1, hq = grp & 1; unsigned w[4];
#pragma unroll
              for (int k = 0; k < 4; ++k) { const int j0 = 2 * k, j1 = 2 * k + 1; const int k0 = tt * 32 + 16 * sk + 8 * (j0 >> 2) + 4 * hq + (j0 & 3), k1 = tt * 32 + 16 * sk + 8 * (j1 >> 2) + 4 * hq + (j1 & 3);
                  w[k] = (unsigned)tile[k0 * 66 + d] | ((unsigned)tile[k1 * 66 + d] << 16); }
              u32x4 o; o.x = w[0]; o.y = w[1]; o.z = w[2]; o.w = w[3];
              *(u32x4*)(vT + (((size_t)b * 128 + (p0 >> 5) + tt) * 64 + d) * 32 + sk * 16 + hq * 8) = o; }
        }
        __syncthreads();
        { const int tl = tid >> 3, ch = tid & 7, pos = p0 + tl; const bf16_t* row = proj + (size_t)(tok0 + tl) * PN;
          const size_t fo = ((((size_t)b * 128 + (pos >> 5)) * 4 + (ch >> 1)) * 64 + (ch & 1) * 32 + (pos & 31)) * 8;
          *(u32x4*)((bf16_t*)(ws + KF_DK) + fo) = *(const u32x4*)(row + C_DK + ch * 8);
          *(u32x4*)((bf16_t*)(ws + KF_NKS) + fo) = *(const u32x4*)(row + C_NKS + ch * 8);
          *(u32x4*)((bf16_t*)(ws + KF_NKW) + fo) = *(const u32x4*)(row + C_NKW + ch * 8);
          if (ch < 4) { const size_t fi = ((((size_t)b * 128 + (pos >> 5)) * 2 + (ch >> 1)) * 64 + (ch & 1) * 32 + (pos & 31)) * 8; *(u32x4*)((bf16_t*)(ws + KF_IK) + fi) = *(const u32x4*)(row + C_IK + ch * 8); } }
        __syncthreads();
    }
}

DI float gelu_tanh(float x) { const float u = 0.7978845608028654f * (x + 0.044715f * x * x * x); const float t = 1.0f - 2.0f / (1.0f + __expf(2.0f * u)); return 0.5f * x * (1.0f + t); }
DI void compress_phase(const Params& p, int l, unsigned char* ws, LAS unsigned char* lds, int c, int G) {
    const int tid = otid(), lane = tid & 63, wave = tid >> 6, r32 = lane & 31, hh = lane >> 5;
    const bf16_t* proj = (const bf16_t*)(ws + BIG_PROJ);
    LAS float* part = (LAS float*)lds;
    LAS bf16_t* hbuf = (LAS bf16_t*)(lds + 65536);
    for (int it = c; it < 64; it += G) {
        const int which = it & 1, mt = (it >> 1) & 7, b = it >> 4;
        const float* cpos = p.in[IN_CPOS] + (size_t)(l * 2 + which) * 32 * 64;
        const bf16_t* w1t = (const bf16_t*)(ws + W_C1) + (size_t)which * 64 * 2048;
        const bf16_t* w2t = (const bf16_t*)(ws + W_C2) + (size_t)which * 64 * 64;
        int cb = mt * 32 + r32; if (cb > 254) cb = 254;
        const bf16_t* src = proj + (size_t)(b * SEQ + 16 * cb) * PN + (which ? C_NVC : C_NKC);
        f32x16 acc[2];
#pragma unroll
        for (int n = 0; n < 2; ++n)
#pragma unroll
            for (int r = 0; r < 16; ++r) acc[n][r] = 0.f;
        for (int ks = wave * 16; ks < wave * 16 + 16; ++ks) {
            const int k0 = ks * 16 + hh * 8, lt = k0 >> 6, d = k0 & 63;
            const u32x4 raw = *(const u32x4*)(src + (size_t)lt * PN + d);
            const f32x4 p0 = *(const f32x4*)(cpos + lt * 64 + d), p1 = *(const f32x4*)(cpos + lt * 64 + d + 4);
            u32x4 av; av.x = pk2(__uint_as_float(raw.x << 16) + p0[0], __uint_as_float(raw.x & 0xffff0000u) + p0[1]); av.y = pk2(__uint_as_float(raw.y << 16) + p0[2], __uint_as_float(raw.y & 0xffff0000u) + p0[3]);
            av.z = pk2(__uint_as_float(raw.z << 16) + p1[0], __uint_as_float(raw.z & 0xffff0000u) + p1[1]); av.w = pk2(__uint_as_float(raw.w << 16) + p1[2], __uint_as_float(raw.w & 0xffff0000u) + p1[3]);
            const bf16x8 a = __builtin_bit_cast(bf16x8, av);
#pragma unroll
            for (int n = 0; n < 2; ++n) { const bf16x8 bb = *(const bf16x8*)(w1t + (size_t)(n * 32 + r32) * 2048 + ks * 16 + hh * 8); acc[n] = MFMA32(a, bb, acc[n]); }
        }
        __syncthreads();
#pragma unroll
        for (int n = 0; n < 2; ++n)
#pragma unroll
            for (int r = 0; r < 16; ++r) part[(wave * 32 + crow(r, hh)) * 64 + n * 32 + r32] = acc[n][r];
        __syncthreads();
        for (int e = tid; e < 32 * 64; e += NTHREADS) { float sacc = 0.f;
#pragma unroll
            for (int w = 0; w < 8; ++w) sacc += part[w * 2048 + e];
            hbuf[(e >> 6) * 72 + (e & 63)] = f2bf(gelu_tanh(sacc)); }
        __syncthreads();
        if (wave == 0) {
            f32x16 o[2];
#pragma unroll
            for (int n = 0; n < 2; ++n)
#pragma unroll
                for (int r = 0; r < 16; ++r) o[n][r] = 0.f;
#pragma unroll
            for (int ks = 0; ks < 4; ++ks) { const bf16x8 a = *(const LAS bf16x8*)(hbuf + r32 * 72 + ks * 16 + hh * 8);
#pragma unroll
                for (int n = 0; n < 2; ++n) { const bf16x8 bb = *(const bf16x8*)(w2t + (size_t)(n * 32 + r32) * 64 + ks * 16 + hh * 8); o[n] = MFMA32(a, bb, o[n]); } }
#pragma unroll
            for (int n = 0; n < 2; ++n)
#pragma unroll
                for (int r = 0; r < 16; ++r) { const int cbi = mt * 32 + crow(r, hh), col = n * 32 + r32;
                    if (which == 0) ((bf16_t*)(ws + S_KCMP))[((((size_t)b * 8 + (cbi >> 5)) * 4 + (col >> 4)) * 64 + ((col >> 3) & 1) * 32 + (cbi & 31)) * 8 + (col & 7)] = f2bf(o[n][r]);
                    else { const int k = cbi & 31, pos = (k >> 4) * 16 + ((k >> 2) & 1) * 8 + ((k >> 3) & 1) * 4 + (k & 3); ((bf16_t*)(ws + S_VCMPT))[(((size_t)b * 8 + (cbi >> 5)) * 64 + col) * 32 + pos] = f2bf(o[n][r]); } }
        }
        __syncthreads();
    }
}

DI float ret_lg(int h) { return log1pf(-exp2f(-5.0f - (float)h)); }
DI void ret_state_phase(unsigned char* ws, int c, int G) {
    const int tid = otid(), lane = tid & 63, wave = tid >> 6, r32 = lane & 31, hh = lane >> 5;
    const bf16_t* proj = (const bf16_t*)(ws + BIG_PROJ); bf16_t* rst = (bf16_t*)(ws + X_RST);
    for (int it = c * NWAVES + wave; it < NB * 32 * 4; it += G * NWAVES) {
        const int h = it & 3, n = (it >> 2) & 31, b = it >> 7; const float lg = ret_lg(h);
        const bf16_t* base = proj + (size_t)(b * SEQ + n * 128) * PN;
        f32x16 acc[2];
#pragma unroll
        for (int q = 0; q < 2; ++q)
#pragma unroll
            for (int r = 0; r < 16; ++r) acc[q][r] = 0.f;
        for (int ks = 0; ks < 8; ++ks) {
            bf16x8 a, b0, b1;
#pragma unroll
            for (int j = 0; j < 8; ++j) { const int tok = ks * 16 + hh * 8 + j; const bf16_t* row = base + (size_t)tok * PN;
                a[j] = (short)f2bf(bf2f(row[C_RK + h * 32 + r32]) * __expf((float)(127 - tok) * lg));
                b0[j] = (short)row[C_RV + h * 64 + r32]; b1[j] = (short)row[C_RV + h * 64 + 32 + r32]; }
            acc[0] = MFMA32(a, b0, acc[0]); acc[1] = MFMA32(a, b1, acc[1]);
        }
        bf16_t* dst = rst + (size_t)it * 64 * 32;
#pragma unroll
        for (int q = 0; q < 2; ++q)
#pragma unroll
            for (int r = 0; r < 16; ++r) dst[(q * 32 + r32) * 32 + crow(r, hh)] = f2bf(acc[q][r]);
    }
}
DI void ret_scan_phase(unsigned char* ws, int c, int G) {
    const int tid = otid(); bf16_t* rst = (bf16_t*)(ws + X_RST);
    for (int e = c * NTHREADS + tid; e < NB * 4 * 2048; e += G * NTHREADS) {
        const int el = e & 2047, h = (e >> 11) & 3, b = e >> 13; const float cd = __expf(128.0f * ret_lg(h));
        float st = 0.f;
        for (int n = 0; n < 32; ++n) { bf16_t* ptr = rst + ((size_t)((b * 32 + n) * 4 + h)) * 2048 + el; const float cin = bf2f(*ptr); *ptr = f2bf(st); st = st * cd + cin; }
    }
}
DI void ret_out_phase(unsigned char* ws, LAS unsigned char* lds, int c, int G) {
    const int tid = otid(), lane = tid & 63, wave = tid >> 6, r32 = lane & 31, hh = lane >> 5;
    const bf16_t* proj = (const bf16_t*)(ws + BIG_PROJ); const bf16_t* rst = (const bf16_t*)(ws + X_RST); bf16_t* ys = (bf16_t*)(ws + WS_YS);
    LAS bf16_t* Sb = (LAS bf16_t*)lds;
    LAS float* ob = (LAS float*)(lds + 128 * 136 * 2);
    for (int it = c; it < NB * 32 * 4; it += G) {
        const int h = it & 3, n = (it >> 2) & 31, b = it >> 7; const float lg = ret_lg(h);
        const bf16_t* base = proj + (size_t)(b * SEQ + n * 128) * PN;
        const int mi = wave >> 1;
        { f32x16 sacc[2];
#pragma unroll
          for (int q = 0; q < 2; ++q)
#pragma unroll
              for (int r = 0; r < 16; ++r) sacc[q][r] = 0.f;
#pragma unroll
          for (int ks = 0; ks < 2; ++ks) { const bf16x8 a = *(const bf16x8*)(base + (size_t)(mi * 32 + r32) * PN + C_RQ + h * 32 + ks * 16 + hh * 8);
#pragma unroll
              for (int q = 0; q < 2; ++q) { const int nj = (wave & 1) * 2 + q; const bf16x8 bb = *(const bf16x8*)(base + (size_t)(nj * 32 + r32) * PN + C_RK + h * 32 + ks * 16 + hh * 8); sacc[q] = MFMA32(a, bb, sacc[q]); } }
#pragma unroll
          for (int q = 0; q < 2; ++q) { const int j = ((wave & 1) * 2 + q) * 32 + r32;
#pragma unroll
              for (int r = 0; r < 16; ++r) { const int i = mi * 32 + crow(r, hh); const float dec = i >= j ? __expf((float)(i - j) * lg) : 0.f; Sb[i * 136 + j] = f2bf(sacc[q][r] * dec); } }
        }
        __syncthreads();
        { const int ni = wave & 1; f32x16 o;
#pragma unroll
          for (int r = 0; r < 16; ++r) o[r] = 0.f;
          for (int ks = 0; ks < 8; ++ks) { const bf16x8 a = *(const LAS bf16x8*)(Sb + (mi * 32 + r32) * 136 + ks * 16 + hh * 8); bf16x8 bb;
#pragma unroll
              for (int j = 0; j < 8; ++j) bb[j] = (short)base[(size_t)(ks * 16 + hh * 8 + j) * PN + C_RV + h * 64 + ni * 32 + r32];
              o = MFMA32(a, bb, o); }
          f32x16 cr;
#pragma unroll
          for (int r = 0; r < 16; ++r) cr[r] = 0.f;
          const bf16_t* prev = rst + (size_t)it * 2048;
#pragma unroll
          for (int ks = 0; ks < 2; ++ks) { const bf16x8 a = *(const bf16x8*)(base + (size_t)(mi * 32 + r32) * PN + C_RQ + h * 32 + ks * 16 + hh * 8);
              const bf16x8 bb = *(const bf16x8*)(prev + (ni * 32 + r32) * 32 + ks * 16 + hh * 8); cr = MFMA32(a, bb, cr); }
#pragma unroll
          for (int r = 0; r < 16; ++r) { const int i = mi * 32 + crow(r, hh); ob[i * 65 + ni * 32 + r32] = o[r] + cr[r] * __expf((float)(i + 1) * lg); }
        }
        __syncthreads();
        { const int i = tid >> 2, q4 = tid & 3; float v[16], sm = 0.f;
#pragma unroll
          for (int k = 0; k < 16; ++k) { v[k] = ob[i * 65 + q4 * 16 + k]; sm += v[k]; }
          sm += __shfl_xor(sm, 1); sm += __shfl_xor(sm, 2); const float mean = sm * (1.f / 64.f); float s2 = 0.f;
#pragma unroll
          for (int k = 0; k < 16; ++k) { v[k] -= mean; s2 += v[k] * v[k]; }
          s2 += __shfl_xor(s2, 1); s2 += __shfl_xor(s2, 2); const float rstd = 1.0f / sqrtf(s2 * (1.f / 64.f) + LN_EPS);
          const bf16_t* grow = base + (size_t)i * PN + C_RG + h * 64 + q4 * 16; bf16_t* yrow = ys + (size_t)(b * SEQ + n * 128 + i) * DM + h * 64 + q4 * 16;
#pragma unroll
          for (int k = 0; k < 16; ++k) yrow[k] = f2bf(siluf_(bf2f(grow[k])) * (v[k] * rstd)); }
        __syncthreads();
    }
}

DI float softplusf_(float x) { return x > 20.f ? x : log1pf(__expf(x)); }
DI float conv_silu(const bf16_t* projb, int pos, int ch, const float* cw, const float* cb) {
    float a = cb[ch];
#pragma unroll
    for (int k = 0; k < 4; ++k) { const int pp = pos - 3 + k; if (pp >= 0) a += cw[k * 768 + ch] * bf2f(projb[(size_t)pp * PN + C_SX + ch]); }
    return siluf_(a);
}
DI void ssd_state_phase(const Params& p, int l, unsigned char* ws, LAS unsigned char* lds, int c, int G) {
    const int tid = otid(), lane = tid & 63, wave = tid >> 6, r32 = lane & 31, hh = lane >> 5;
    const bf16_t* proj = (const bf16_t*)(ws + BIG_PROJ); bf16_t* sst = (bf16_t*)(ws + X_SST); float* cdec = (float*)(ws + X_CDEC);
    const float* cw = p.in[IN_CONVW] + (size_t)l * 4 * 768; const float* cb = p.in[IN_CONVB] + (size_t)l * 768;
    LAS bf16_t* XT = (LAS bf16_t*)lds;
    LAS bf16_t* BT = (LAS bf16_t*)(lds + 64 * 136 * 2);
    LAS float* dtv = (LAS float*)(lds + 192 * 136 * 2);
    for (int it = c; it < NB * 32 * 4; it += G) {
        const int h = it & 3, ch = (it >> 2) & 31, b = it >> 7, g = h >> 1;
        const bf16_t* projb = proj + (size_t)b * SEQ * PN; const int pos0 = ch * 128;
        if (tid < 128) { const float dt = softplusf_(bf2f(projb[(size_t)(pos0 + tid) * PN + C_SDT + h]) + p.in[IN_DTB][l * 4 + h]); dtv[tid] = dt; dtv[128 + tid] = -__expf(p.in[IN_ALOG][l * 4 + h]) * dt; }
        __syncthreads();
        if (tid < 128) { float a = 0.f; for (int j = 0; j <= tid; ++j) a += dtv[128 + j]; dtv[256 + tid] = a; }
        __syncthreads();
        const float alast = dtv[256 + 127];
        if (tid == 0) cdec[(b * 32 + ch) * 4 + h] = __expf(alast);
        { const int pp = tid & 63, lg8 = tid >> 6;
          for (int k = 0; k < 16; ++k) { const int ll = lg8 * 16 + k; const float xs = conv_silu(projb, pos0 + ll, h * 64 + pp, cw, cb); XT[pp * 136 + ll] = f2bf(xs * dtv[ll] * __expf(alast - dtv[256 + ll])); } }
        { const int n = tid & 127, lg4 = tid >> 7;
          for (int k = 0; k < 32; ++k) { const int ll = lg4 * 32 + k; BT[n * 136 + ll] = f2bf(conv_silu(projb, pos0 + ll, 256 + g * 128 + n, cw, cb)); } }
        __syncthreads();
        { const int mi = wave >> 2, ni = wave & 3; f32x16 acc;
#pragma unroll
          for (int r = 0; r < 16; ++r) acc[r] = 0.f;
#pragma unroll
          for (int ks = 0; ks < 8; ++ks) { const bf16x8 a = *(const LAS bf16x8*)(XT + (mi * 32 + r32) * 136 + ks * 16 + hh * 8); const bf16x8 bb = *(const LAS bf16x8*)(BT + (ni * 32 + r32) * 136 + ks * 16 + hh * 8); acc = MFMA32(a, bb, acc); }
          bf16_t* dst = sst + (size_t)((ch * NB + b) * 4 + h) * 8192;
#pragma unroll
          for (int r = 0; r < 16; ++r) dst[(mi * 32 + crow(r, hh)) * 128 + ni * 32 + r32] = f2bf(acc[r]); }
        __syncthreads();
    }
}
DI void ssd_scan_phase(unsigned char* ws, int c, int G) {
    const int tid = otid(); bf16_t* sst = (bf16_t*)(ws + X_SST); const float* cdec = (const float*)(ws + X_CDEC);
    for (int e = c * NTHREADS + tid; e < NB * 4 * 8192; e += G * NTHREADS) {
        const int el = e & 8191, h = (e >> 13) & 3, b = e >> 15; float st = 0.f;
        for (int ch = 0; ch < 32; ++ch) { bf16_t* ptr = sst + (size_t)((ch * NB + b) * 4 + h) * 8192 + el; const float cin = bf2f(*ptr); *ptr = f2bf(st); st = st * cdec[(b * 32 + ch) * 4 + h] + cin; }
    }
}
DI void ssd_out_phase(const Params& p, int l, unsigned char* ws, LAS unsigned char* lds, int c, int G) {
    const int tid = otid(), lane = tid & 63, wave = tid >> 6, r32 = lane & 31, hh = lane >> 5;
    const bf16_t* proj = (const bf16_t*)(ws + BIG_PROJ); const bf16_t* sst = (const bf16_t*)(ws + X_SST); bf16_t* ys = (bf16_t*)(ws + WS_YS);
    const float* cw = p.in[IN_CONVW] + (size_t)l * 4 * 768; const float* cb = p.in[IN_CONVB] + (size_t)l * 768;
    LAS bf16_t* Cn = (LAS bf16_t*)lds;
    LAS bf16_t* Bn = (LAS bf16_t*)(lds + 34816);
    LAS bf16_t* XT = (LAS bf16_t*)(lds + 69632);
    LAS bf16_t* xsn = (LAS bf16_t*)(lds + 87040);
    LAS bf16_t* yb = (LAS bf16_t*)(lds + 103936);
    LAS float* dtv = (LAS float*)(lds + 138752);
    for (int it = c; it < NB * 32 * 2; it += G) {
        const int g = it & 1, ch = (it >> 1) & 31, b = it >> 6;
        const bf16_t* projb = proj + (size_t)b * SEQ * PN; const int pos0 = ch * 128;
        if (tid < 256) { const int hd = tid >> 7, ll = tid & 127, h = 2 * g + hd; const float dt = softplusf_(bf2f(projb[(size_t)(pos0 + ll) * PN + C_SDT + h]) + p.in[IN_DTB][l * 4 + h]); dtv[tid] = dt; dtv[256 + tid] = -__expf(p.in[IN_ALOG][l * 4 + h]) * dt; }
        __syncthreads();
        if (tid < 256) { const int hd = tid >> 7, ll = tid & 127; float a = 0.f; for (int j = 0; j <= ll; ++j) a += dtv[256 + hd * 128 + j]; dtv[512 + tid] = a; }
        { const int n = tid & 127, lg4 = tid >> 7;
          for (int k = 0; k < 32; ++k) { const int ll = lg4 * 32 + k; Bn[ll * 136 + n] = f2bf(conv_silu(projb, pos0 + ll, 256 + g * 128 + n, cw, cb)); Cn[ll * 136 + n] = f2bf(conv_silu(projb, pos0 + ll, 512 + g * 128 + n, cw, cb)); } }
        __syncthreads();
        const int mi = wave >> 1;
        f32x16 cbt[2];
#pragma unroll
        for (int q = 0; q < 2; ++q)
#pragma unroll
            for (int r = 0; r < 16; ++r) cbt[q][r] = 0.f;
#pragma unroll
        for (int ks = 0; ks < 8; ++ks) { const bf16x8 a = *(const LAS bf16x8*)(Cn + (mi * 32 + r32) * 136 + ks * 16 + hh * 8);
#pragma unroll
            for (int q = 0; q < 2; ++q) { const bf16x8 bb = *(const LAS bf16x8*)(Bn + (((wave & 1) * 2 + q) * 32 + r32) * 136 + ks * 16 + hh * 8); cbt[q] = MFMA32(a, bb, cbt[q]); } }
        __syncthreads();
#pragma unroll 1
        for (int hd = 0; hd < 2; ++hd) {
            const int h = 2 * g + hd; LAS float* acs = dtv + 512 + hd * 128; LAS float* dth = dtv + hd * 128;
            { const int pp = tid & 63, lg8 = tid >> 6;
              for (int k = 0; k < 16; ++k) { const int ll = lg8 * 16 + k; const float xs = conv_silu(projb, pos0 + ll, h * 64 + pp, cw, cb); XT[pp * 136 + ll] = f2bf(xs * dth[ll]); xsn[ll * 66 + pp] = f2bf(xs); } }
#pragma unroll
            for (int q = 0; q < 2; ++q) { const int sidx = ((wave & 1) * 2 + q) * 32 + r32; const float as = acs[sidx];
#pragma unroll
                for (int r = 0; r < 16; ++r) { const int li = mi * 32 + crow(r, hh); const float lm = li >= sidx ? __expf(acs[li] - as) : 0.f; Bn[li * 136 + sidx] = f2bf(cbt[q][r] * lm); } }
            __syncthreads();
            { const int ni = wave & 1; f32x16 yd, yo;
#pragma unroll
              for (int r = 0; r < 16; ++r) { yd[r] = 0.f; yo[r] = 0.f; }
              const bf16_t* prev = sst + (size_t)((ch * NB + b) * 4 + h) * 8192 + (size_t)(ni * 32 + r32) * 128 + hh * 8;
#pragma unroll
              for (int ks = 0; ks < 8; ++ks) { const bf16x8 a = *(const LAS bf16x8*)(Bn + (mi * 32 + r32) * 136 + ks * 16 + hh * 8); const bf16x8 bb = *(const LAS bf16x8*)(XT + (ni * 32 + r32) * 136 + ks * 16 + hh * 8); yd = MFMA32(a, bb, yd);
                  const bf16x8 a2 = *(const LAS bf16x8*)(Cn + (mi * 32 + r32) * 136 + ks * 16 + hh * 8); const bf16x8 b2 = *(const bf16x8*)(prev + ks * 16); yo = MFMA32(a2, b2, yo); }
              const int pp = ni * 32 + r32; const float dsk = p.in[IN_DSKIP][l * 4 + h];
#pragma unroll
              for (int r = 0; r < 16; ++r) { const int li = mi * 32 + crow(r, hh); const float z = bf2f(projb[(size_t)(pos0 + li) * PN + C_SZ + h * 64 + pp]);
                  const float y = yd[r] + __expf(acs[li]) * yo[r] + bf2f(xsn[li * 66 + pp]) * dsk; yb[li * 136 + hd * 64 + pp] = f2bf(y * siluf_(z)); } }
            __syncthreads();
        }
        { const int li = tid >> 2, q4 = tid & 3; float v[32], ss = 0.f;
#pragma unroll
          for (int k = 0; k < 32; ++k) { v[k] = bf2f(yb[li * 136 + q4 * 32 + k]); ss += v[k] * v[k]; }
          ss += __shfl_xor(ss, 1); ss += __shfl_xor(ss, 2); const float rs = 1.0f / sqrtf(ss * (1.f / 128.f) + LN_EPS);
          const float* ng = p.in[IN_SNG] + (size_t)l * 256 + g * 128 + q4 * 32; bf16_t* yrow = ys + (size_t)(b * SEQ + pos0 + li) * DM + 768 + g * 128 + q4 * 32;
#pragma unroll
          for (int k = 0; k < 32; ++k) yrow[k] = f2bf(v[k] * rs * ng[k]); }
        __syncthreads();
    }
}

constexpr int L_PST = 131072, L_RED = L_PST + 20480, L_MISC = L_RED + 2304;
template <class Mask, bool SAVE_E>
DI void mqa_attn(LAS unsigned char* lds, int tid, const bf16_t* qbase, const bf16_t* kbase, int kstride, const bf16_t* vT, int vstride, int tile_lo, int tile_hi, float scale,
                 const Mask& mask, LAS float* oslot, LAS float* lsum, LAS float* esave, int estr) {
    tid = launder(tid);
    const int lane = tid & 63, wave = tid >> 6, r32 = lane & 31, hh = lane >> 5;
    LAS bf16_t* Pst = (LAS bf16_t*)(lds + L_PST + wave * 2560);
    LAS float* redm = (LAS float*)(lds + L_RED); LAS float* redl = redm + 256;
    bf16x8 qa[4];
#pragma unroll
    for (int ks = 0; ks < 4; ++ks) qa[ks] = *(const bf16x8*)(qbase + (size_t)(r32 >> 2) * PN + (r32 & 3) * 64 + ks * 16 + hh * 8);
    float m[16];
#pragma unroll
    for (int r = 0; r < 16; ++r) m[r] = -1e30f;
    bf16x8 kf[4];
    { const int t1 = tile_lo + wave < tile_hi ? tile_lo + wave : tile_lo; const bf16_t* kp = kbase + (size_t)(t1 * 32 + r32) * kstride + hh * 8;
#pragma unroll
      for (int ks = 0; ks < 4; ++ks) kf[ks] = *(const bf16x8*)(kp + ks * 16); }
#pragma unroll 1
    for (int tile = tile_lo + wave; tile < tile_hi; tile += 8) {
        const int key = tile * 32 + r32; const int nxt = tile + 8 < tile_hi ? tile + 8 : tile; const bf16_t* kp = kbase + (size_t)(nxt * 32 + r32) * kstride + hh * 8;
        bf16x8 kn[4];
#pragma unroll
        for (int ks = 0; ks < 4; ++ks) kn[ks] = *(const bf16x8*)(kp + ks * 16);
        f32x16 S;
#pragma unroll
        for (int r = 0; r < 16; ++r) S[r] = 0.f;
#pragma unroll
        for (int ks = 0; ks < 4; ++ks) S = MFMA32(qa[ks], kf[ks], S);
#pragma unroll
        for (int g = 0; g < 4; ++g) { const bool ok = mask(2 * g + hh, key);
#pragma unroll
            for (int i = 0; i < 4; ++i) m[4 * g + i] = ok ? fmaxf(m[4 * g + i], S[4 * g + i]) : m[4 * g + i]; }
#pragma unroll
        for (int ks = 0; ks < 4; ++ks) kf[ks] = kn[ks];
    }
#pragma unroll
    for (int r = 0; r < 16; ++r) { m[r] = half_max(m[r]); if (r32 == 0) redm[wave * 32 + crow(r, hh)] = m[r]; }
    __syncthreads();
    LAS float* mfin = (LAS float*)(lds + L_RED + 2048);
    if (tid < 32) { float mm = redm[tid];
#pragma unroll
        for (int w = 1; w < 8; ++w) mm = fmaxf(mm, redm[w * 32 + tid]);
        mfin[tid] = mm; }
    __syncthreads();
#pragma unroll
    for (int r = 0; r < 16; ++r) m[r] = mfin[crow(r, hh)];
    float lr[16]; f32x16 O[2]; const float c1 = scale * 1.4426950408889634f;
#pragma unroll
    for (int r = 0; r < 16; ++r) { lr[r] = 0.f; O[0][r] = 0.f; O[1][r] = 0.f; m[r] *= c1; }
    bf16x8 vf[4];
    { const int t1 = tile_lo + wave < tile_hi ? tile_lo + wave : tile_lo; const bf16_t* kp = kbase + (size_t)(t1 * 32 + r32) * kstride + hh * 8;
#pragma unroll
      for (int ks = 0; ks < 4; ++ks) kf[ks] = *(const bf16x8*)(kp + ks * 16);
#pragma unroll
      for (int q = 0; q < 4; ++q) vf[q] = *(const bf16x8*)(vT + (size_t)((q & 1) * 32 + r32) * vstride + t1 * 32 + (q >> 1) * 16 + hh * 8); }
#pragma unroll 1
    for (int tile = tile_lo + wave; tile < tile_hi; tile += 8) {
        const int key = tile * 32 + r32; const int nxt = tile + 8 < tile_hi ? tile + 8 : tile; const bf16_t* kp = kbase + (size_t)(nxt * 32 + r32) * kstride + hh * 8;
        bf16x8 kn[4], vn[4];
#pragma unroll
        for (int ks = 0; ks < 4; ++ks) kn[ks] = *(const bf16x8*)(kp + ks * 16);
#pragma unroll
        for (int q = 0; q < 4; ++q) vn[q] = *(const bf16x8*)(vT + (size_t)((q & 1) * 32 + r32) * vstride + nxt * 32 + (q >> 1) * 16 + hh * 8);
        f32x16 S;
#pragma unroll
        for (int r = 0; r < 16; ++r) S[r] = 0.f;
#pragma unroll
        for (int ks = 0; ks < 4; ++ks) S = MFMA32(qa[ks], kf[ks], S);
#pragma unroll
        for (int g = 0; g < 4; ++g) { const bool ok = mask(2 * g + hh, key);
#pragma unroll
            for (int i = 0; i < 4; ++i) { const int r = 4 * g + i; const float pe = ok ? __builtin_amdgcn_exp2f(__builtin_fmaf(S[r], c1, -m[r])) : 0.f; lr[r] += pe; Pst[crow(r, hh) * 40 + r32] = (bf16_t)pk2(pe, 0.f);
                if (SAVE_E) esave[crow(r, hh) * estr + key] = pe; } }
#pragma unroll
        for (int ks = 0; ks < 2; ++ks) { const bf16x8 a = *(const LAS bf16x8*)(Pst + r32 * 40 + ks * 16 + hh * 8);
#pragma unroll
            for (int n = 0; n < 2; ++n) O[n] = MFMA32(a, vf[ks * 2 + n], O[n]); }
#pragma unroll
        for (int ks = 0; ks < 4; ++ks) { kf[ks] = kn[ks]; vf[ks] = vn[ks]; }
    }
#pragma unroll
    for (int r = 0; r < 16; ++r) { lr[r] = half_sum(lr[r]); if (r32 == 0) redl[wave * 32 + crow(r, hh)] = lr[r]; }
    __syncthreads();
    LAS float* part = (LAS float*)lds;
#pragma unroll
    for (int n = 0; n < 2; ++n)
#pragma unroll
        for (int r = 0; r < 16; ++r) part[(wave * 32 + crow(r, hh)) * 64 + n * 32 + r32] = O[n][r];
    __syncthreads();
    { const int row = tid >> 4, d4 = (tid & 15) * 4; f32x4 a = {0.f, 0.f, 0.f, 0.f}; float L = 0.f;
#pragma unroll
      for (int w = 0; w < 8; ++w) { a += *(const LAS f32x4*)(part + (w * 32 + row) * 64 + d4); L += redl[w * 32 + row]; }
      const float inv = 1.0f / fmaxf(L, 1e-30f);
      *(LAS f32x4*)(oslot + row * 64 + d4) = a * inv; if ((tid & 15) == 0) lsum[row] = L; }
    __syncthreads();
}
DI void item_map(int j, int c, int G, int& b, int& t0, bool& valid) { const int idx = j * G + ((j & 1) ? (G - 1 - c) : c); valid = idx < 2048; b = idx & 3; t0 = (idx >> 2) * 8; }

DI int wave_sum_i(int v) {
#pragma unroll
    for (int o = 1; o < 64; o <<= 1) v += __shfl_xor(v, o);
    return v;
}
DI unsigned sort_key(float f) { f = f + 0.0f; const unsigned u = __float_as_uint(f); return (u >> 31) ? ~u : (u | 0x80000000u); }
template <int NR> DI void dsa_select(const LAS float* srow, int t, int lane, unsigned long long* bits) {
    unsigned v[NR];
#pragma unroll
    for (int j = 0; j < NR; ++j) { const int sidx = lane + 64 * j; v[j] = sidx <= t ? sort_key(srow[sidx]) : 0u; }
    unsigned T = 0; int cut = 4095; bool done = false;
#pragma unroll 1
    for (int bit = 31; bit >= 0; --bit) { const unsigned cand = T | (1u << bit); int cnt = 0;
#pragma unroll
        for (int j = 0; j < NR; ++j) cnt += (v[j] >= cand) ? 1 : 0;
        cnt = wave_sum_i(cnt);
        if (cnt >= 256) T = cand;
        if (cnt == 256) { done = true; break; } }
    if (!done) {
        int cgt = 0, ceq = 0;
#pragma unroll
        for (int j = 0; j < NR; ++j) { cgt += (v[j] > T) ? 1 : 0; ceq += (v[j] == T) ? 1 : 0; }
        cgt = wave_sum_i(cgt); ceq = wave_sum_i(ceq);
        const int need = 256 - cgt;
        if (ceq > need) { int cc = 0;
#pragma unroll 1
            for (int bit = 11; bit >= 0; --bit) { const int cand = cc | (1 << bit); int cnt = 0;
#pragma unroll
                for (int j = 0; j < NR; ++j) cnt += (v[j] == T && (lane + 64 * j) < cand) ? 1 : 0;
                cnt = wave_sum_i(cnt);
                if (cnt < need) cc = cand; }
            cut = cc; }
    }
    unsigned mlo = 0u, mhi = 0u;
#pragma unroll
    for (int j = 0; j < NR; ++j) { unsigned vj = v[j]; asm volatile("" : "+v"(vj) : "v"(mlo), "v"(mhi));
        const unsigned long long bal = __ballot(vj > T || (vj == T && (lane + 64 * j) <= cut)); mlo = (lane == j) ? (unsigned)bal : mlo; mhi = (lane == j) ? (unsigned)(bal >> 32) : mhi; }
    if (lane < NR) bits[lane] = ((unsigned long long)mhi << 32) | mlo;
}

DI void lse_merge(f32x16 (&O)[2], float (&lr)[16], float (&mc)[16], const LAS float* xo, const LAS float* xlm, int lane, int hh) {
#pragma unroll
    for (int r = 0; r < 16; ++r) {
        const float l2 = xlm[hh * 16 + r], m2 = xlm[32 + hh * 16 + r];
        const float M = fmaxf(mc[r], m2), w1 = __builtin_amdgcn_exp2f(mc[r] - M), w2 = __builtin_amdgcn_exp2f(m2 - M);
        const float inv = 1.0f / fmaxf(lr[r] * w1 + l2 * w2, 1e-30f);
        O[0][r] = (O[0][r] * w1 + xo[r * 64 + lane] * w2) * inv; O[1][r] = (O[1][r] * w1 + xo[(16 + r) * 64 + lane] * w2) * inv;
    }
}
DI void put_partial(const f32x16 (&O)[2], const float (&lr)[16], const float (&mc)[16], LAS float* xo, LAS float* xlm, int lane, int r32, int hh) {
#pragma unroll
    for (int r = 0; r < 16; ++r) { xo[r * 64 + lane] = O[0][r]; xo[(16 + r) * 64 + lane] = O[1][r]; if (r32 == 0) { xlm[hh * 16 + r] = lr[r]; xlm[32 + hh * 16 + r] = mc[r]; } }
}

typedef __bf16 bf16v2 __attribute__((ext_vector_type(2)));
typedef float f32v2 __attribute__((ext_vector_type(2)));
DI unsigned cvt2(float a, float b) { f32v2 v = {a, b}; return __builtin_bit_cast(unsigned, __builtin_convertvector(v, bf16v2)); }
DI unsigned upto(int base, int lim) { const int d = lim - base; return d >= 31 ? ~0u : (d < 0 ? 0u : (2u << d) - 1u); }
DI unsigned from(int base, int lo) { const int d = lo - base; return d <= 0 ? ~0u : (d > 31 ? 0u : ~0u << d); }
#define CBIT(r) (8 * ((r) >> 2) + ((r) & 3))
template <class Mask>
DI void wave_attn_t(const bf16x8 (&qf)[4], const bf16_t* kF, const bf16_t* vT, int tile_lo, int tile_hi, float c1, const Mask& mask,
                    int lane, int hh, f32x16 (&O)[2], float& lsum, float& mc) {
    const int r32 = lane & 31;
    float m = -1e30f;
    bf16x8 kf[4];
    { const bf16_t* kp = kF + ((size_t)tile_lo * 256 + lane) * 8;
#pragma unroll
      for (int ks = 0; ks < 4; ++ks) kf[ks] = *(const bf16x8*)(kp + ks * 512); }
#pragma unroll 1
    for (int tile = tile_lo; tile < tile_hi; ++tile) {
        const int nxt = tile + 1 < tile_hi ? tile + 1 : tile; const bf16_t* kp = kF + ((size_t)nxt * 256 + lane) * 8;
        bf16x8 kn[4];
#pragma unroll
        for (int ks = 0; ks < 4; ++ks) kn[ks] = *(const bf16x8*)(kp + ks * 512);
        f32x16 S;
#pragma unroll
        for (int r = 0; r < 16; ++r) S[r] = 0.f;
#pragma unroll
        for (int ks = 0; ks < 4; ++ks) S = MFMA32(kf[ks], qf[ks], S);
        const unsigned al = mask(tile) >> (4 * hh);
#pragma unroll
        for (int r = 0; r < 16; ++r) m = ((al >> CBIT(r)) & 1u) ? fmaxf(m, S[r]) : m;
#pragma unroll
        for (int ks = 0; ks < 4; ++ks) kf[ks] = kn[ks];
    }
    m = fmaxf(m, __shfl_xor(m, 32)); mc = m * c1;
    float l = 0.f;
#pragma unroll
    for (int r = 0; r < 16; ++r) { O[0][r] = 0.f; O[1][r] = 0.f; }
    { const bf16_t* kp = kF + ((size_t)tile_lo * 256 + lane) * 8;
#pragma unroll
      for (int ks = 0; ks < 4; ++ks) kf[ks] = *(const bf16x8*)(kp + ks * 512); }
#pragma unroll 1
    for (int tile = tile_lo; tile < tile_hi; ++tile) {
        const int nxt = tile + 1 < tile_hi ? tile + 1 : tile; const bf16_t* kp = kF + ((size_t)nxt * 256 + lane) * 8;
        bf16x8 kn[4], vf[4];
#pragma unroll
        for (int ks = 0; ks < 4; ++ks) kn[ks] = *(const bf16x8*)(kp + ks * 512);
#pragma unroll
        for (int q = 0; q < 4; ++q) vf[q] = *(const bf16x8*)(vT + ((size_t)tile * 64 + (q & 1) * 32 + r32) * 32 + (q >> 1) * 16 + hh * 8);
        f32x16 S;
#pragma unroll
        for (int r = 0; r < 16; ++r) S[r] = 0.f;
#pragma unroll
        for (int ks = 0; ks < 4; ++ks) S = MFMA32(kf[ks], qf[ks], S);
        const unsigned al = mask(tile) >> (4 * hh);
        float pe[16];
#pragma unroll
        for (int r = 0; r < 16; ++r) { pe[r] = ((al >> CBIT(r)) & 1u) ? __builtin_amdgcn_exp2f(__builtin_fmaf(S[r], c1, -mc)) : 0.f; l += pe[r]; }
#pragma unroll
        for (int ks = 0; ks < 2; ++ks) { u32x4 pw; pw.x = cvt2(pe[8 * ks], pe[8 * ks + 1]); pw.y = cvt2(pe[8 * ks + 2], pe[8 * ks + 3]); pw.z = cvt2(pe[8 * ks + 4], pe[8 * ks + 5]); pw.w = cvt2(pe[8 * ks + 6], pe[8 * ks + 7]);
            const bf16x8 pf = __builtin_bit_cast(bf16x8, pw);
#pragma unroll
            for (int n = 0; n < 2; ++n) O[n] = MFMA32(vf[ks * 2 + n], pf, O[n]); }
#pragma unroll
        for (int ks = 0; ks < 4; ++ks) kf[ks] = kn[ks];
    }
    lsum = l + __shfl_xor(l, 32);
}
DI void lse_merge_t(f32x16 (&O)[2], float lsum, float mc, const LAS float* xo, const LAS float* xlm, int lane) {
    const float l2 = xlm[lane], m2 = xlm[64 + lane];
    const float M = fmaxf(mc, m2), w1 = __builtin_amdgcn_exp2f(mc - M), w2 = __builtin_amdgcn_exp2f(m2 - M);
    const float inv = 1.0f / fmaxf(lsum * w1 + l2 * w2, 1e-30f), a1 = w1 * inv, a2 = w2 * inv;
#pragma unroll
    for (int r = 0; r < 16; ++r) { O[0][r] = O[0][r] * a1 + xo[r * 64 + lane] * a2; O[1][r] = O[1][r] * a1 + xo[(16 + r) * 64 + lane] * a2; }
}
DI void put_partial_t(const f32x16 (&O)[2], float lsum, float mc, LAS float* xo, LAS float* xlm, int lane) {
#pragma unroll
    for (int r = 0; r < 16; ++r) { xo[r * 64 + lane] = O[0][r]; xo[(16 + r) * 64 + lane] = O[1][r]; }
    xlm[lane] = lsum; xlm[64 + lane] = mc;
}
DI void store_rows_t(const f32x16 (&O)[2], bf16_t* yrow  , int hh) {
#pragma unroll
    for (int n = 0; n < 2; ++n)
#pragma unroll
        for (int g = 0; g < 4; ++g) { u32x2 w; w.x = cvt2(O[n][4 * g], O[n][4 * g + 1]); w.y = cvt2(O[n][4 * g + 2], O[n][4 * g + 3]); *(u32x2*)(yrow + n * 32 + 8 * g + 4 * hh) = w; }
}
struct TBits { int t; const LAS unsigned* w; DI unsigned operator()(int tile) const { return w[tile] & upto(tile * 32, t); } };
struct TCmp { int lim; DI unsigned operator()(int tile) const { return upto(tile * 32, lim); } };
struct TSel { int t; unsigned long long sel; DI unsigned operator()(int tile) const { return ((sel >> (tile >> 1)) & 1ull) ? upto(tile * 32, t) : 0u; } };
struct TWin { int t; DI unsigned operator()(int tile) const { return upto(tile * 32, t) & from(tile * 32, t - 511); } };
struct WBitMask { int tq[4]; const LAS unsigned* w[4]; DI bool operator()(int g, int key) const { return key <= tq[g] && ((w[g][key >> 5] >> (key & 31)) & 1u); } };
template <class Mask>
DI void wave_attn(const bf16x8 (&qa)[4], const bf16_t* kbase, int kstride, const bf16_t* vT, int vstride, int tile_lo, int tile_hi, float c1, const Mask& mask,
                  LAS bf16_t* Pst, int r32, int hh, f32x16 (&O)[2], float (&lr)[16], float (&mc)[16]);
DI void dsa_phase(unsigned char* ws, LAS unsigned char* lds, int c, int G) {
    const bf16_t* proj = (const bf16_t*)(ws + BIG_PROJ); bf16_t* ys = (bf16_t*)(ws + WS_YS);
    unsigned long long* bitsg = (unsigned long long*)(ws + WS_BITS);
    LAS float* sc = (LAS float*)lds;
    const int rounds = (2048 + G - 1) / G;
    for (int j = 0; j < rounds; ++j) {
        int b, t0; bool valid; item_map(j, c, G, b, t0, valid); if (!valid) continue;
        const bf16_t* projb = proj + (size_t)b * SEQ * PN; const int nt = t0 / 32 + 1;
        {
            const int tq = otid(), lane = tq & 63, wave = tq >> 6, r32 = lane & 31, hh = lane >> 5;
            bf16x8 ia[2][2]; LAS float* wt = (LAS float*)(lds + L_PST);
            if (tq < 64) wt[tq] = bf2f(projb[(size_t)(t0 + (tq >> 3)) * PN + C_IW + (tq & 7)]) * 0.0625f;
#pragma unroll
            for (int mt = 0; mt < 2; ++mt) {
#pragma unroll
                for (int ks = 0; ks < 2; ++ks) ia[mt][ks] = *(const bf16x8*)(projb + (size_t)(t0 + mt * 4 + (r32 >> 3)) * PN + C_IQ + (r32 & 7) * 32 + ks * 16 + hh * 8);
            }
            __syncthreads();
            const bf16_t* ikf = (const bf16_t*)(ws + KF_IK) + (size_t)b * SEQ * 32;
            bf16x8 b0, b1;
            { const int t1 = wave < nt ? wave : 0; const bf16_t* kp = ikf + ((size_t)t1 * 128 + lane) * 8; b0 = *(const bf16x8*)kp; b1 = *(const bf16x8*)(kp + 512); }
#pragma unroll 1
            for (int tile = wave; tile < nt; tile += 8) {
                const int key = tile * 32 + r32; const int nxt = tile + 8 < nt ? tile + 8 : tile; const bf16_t* kp = ikf + ((size_t)nxt * 128 + lane) * 8;
                const bf16x8 n0 = *(const bf16x8*)kp, n1 = *(const bf16x8*)(kp + 512);
#pragma unroll
                for (int mt = 0; mt < 2; ++mt) { f32x16 a;
#pragma unroll
                    for (int r = 0; r < 16; ++r) a[r] = 0.f;
                    a = MFMA32(ia[mt][0], b0, a); a = MFMA32(ia[mt][1], b1, a);
#pragma unroll
                    for (int g = 0; g < 4; ++g) { float v = 0.f;
#pragma unroll
                        for (int i = 0; i < 4; ++i) v += wt[(mt * 4 + g) * 8 + 4 * hh + i] * fmaxf(a[4 * g + i], 0.f);
                        v += __shfl_xor(v, 32);
                        if (hh == mt) sc[(mt * 4 + g) * 4096 + key] = v; } }
                b0 = n0; b1 = n1;
            }
        }
        __syncthreads();
        { const int tq = otid(), lane = tq & 63, wave = tq >> 6; const int t = t0 + wave; const LAS float* srow = sc + wave * 4096;
          unsigned long long* bits = bitsg + (size_t)(b * SEQ + t) * 64;
          if (t < 256) { const int lo = lane * 64; bits[lane] = t >= lo + 63 ? ~0ull : (t < lo ? 0ull : ((1ull << (t - lo + 1)) - 1ull)); }
          else if (t < 1024) dsa_select<16>(srow, t, lane, bits);
          else if (t < 2048) dsa_select<32>(srow, t, lane, bits);
          else if (t < 3072) dsa_select<48>(srow, t, lane, bits);
          else dsa_select<64>(srow, t, lane, bits); }
        __syncthreads();
    }
    asm volatile("s_waitcnt vmcnt(0)" ::: "memory");
    __syncthreads();
    {
        const int tid = otid(), lane = tid & 63, wave = tid >> 6, r32 = lane & 31, hh = lane >> 5, pp = wave & 3, hf = wave >> 2;
        LAS unsigned char* wl = lds + wave * 19456; LAS unsigned* bw = (LAS unsigned*)(wl + 2560); LAS float* xo = (LAS float*)(wl + 6656); LAS float* xlm = (LAS float*)(wl + 6656 + 8192);
        LAS unsigned char* pl = lds + (wave ^ 4) * 19456; const LAS float* pxo = (const LAS float*)(pl + 6656); const LAS float* pxlm = (const LAS float*)(pl + 6656 + 8192);
        const float c1 = 0.125f * 1.4426950408889634f;
        f32x16 O[2]; float lsum = 0.f, mc = 0.f;
        int bm = 0, t0m = 0;
#pragma unroll 1
        for (int pass = 0; pass < 2; ++pass) {
            const int j = (pass == 0) == (hf == 0) ? 7 - pp : pp;
            int b, t0; bool valid; item_map(j, c, G, b, t0, valid);
            const bf16_t* projb = proj + (size_t)b * SEQ * PN; const int nt = t0 / 32 + 1; const bf16_t* qb = projb + (size_t)t0 * PN + C_DQ;
            { const u32x4* src = (const u32x4*)(bitsg + (size_t)(b * SEQ + t0) * 64) + lane * 4; LAS unsigned* dst = bw + lane * 16;
#pragma unroll
              for (int q = 0; q < 4; ++q) { const u32x4 v = src[q]; dst[q * 4] = v.x; dst[q * 4 + 1] = v.y; dst[q * 4 + 2] = v.z; dst[q * 4 + 3] = v.w; } }
            bf16x8 qf[4];
#pragma unroll
            for (int ks = 0; ks < 4; ++ks) qf[ks] = *(const bf16x8*)(qb + (size_t)(r32 >> 2) * PN + (r32 & 3) * 64 + ks * 16 + hh * 8);
            TBits mk{t0 + (r32 >> 2), bw + (r32 >> 2) * 128};
            const int mid = nt >> 1;
            wave_attn_t(qf, (const bf16_t*)(ws + KF_DK) + (size_t)b * SEQ * 64, (const bf16_t*)(ws + X_DVT) + (size_t)b * 64 * SEQ, hf ? mid : 0, hf ? nt : mid, c1, mk, lane, hh, O, lsum, mc);
            if (pass == 0) put_partial_t(O, lsum, mc, xo, xlm, lane);
            bm = b; t0m = t0;
        }
        __syncthreads();
        lse_merge_t(O, lsum, mc, pxo, pxlm, lane);
        store_rows_t(O, ys + (size_t)(bm * SEQ + t0m + (r32 >> 2)) * DM + 256 + (r32 & 3) * 64, hh);
    }
    __syncthreads();
}

struct CmpMask { int t0; DI bool operator()(int tl, int key) const { return key <= 254 && 16 * key + 31 <= t0 + tl; } };
struct SelMask { int t0; const LAS unsigned* sel; DI bool operator()(int tl, int key) const { const int blk = key >> 6; return key <= t0 + tl && ((sel[tl * 2 + (blk >> 5)] >> (blk & 31)) & 1u); } };
struct WinMask { int t0; DI bool operator()(int tl, int key) const { const int t = t0 + tl; return key <= t && t - key < 512; } };
template <class Mask>
DI void wave_attn(const bf16x8 (&qa)[4], const bf16_t* kbase, int kstride, const bf16_t* vT, int vstride, int tile_lo, int tile_hi, float c1, const Mask& mask,
                  LAS bf16_t* Pst, int r32, int hh, f32x16 (&O)[2], float (&lr)[16], float (&mc)[16]) {
#pragma unroll
    for (int r = 0; r < 16; ++r) { mc[r] = -1e30f; lr[r] = 0.f; O[0][r] = 0.f; O[1][r] = 0.f; }
    bf16x8 kf[4];
    { const bf16_t* kp = kbase + (size_t)(tile_lo * 32 + r32) * kstride + hh * 8;
#pragma unroll
      for (int ks = 0; ks < 4; ++ks) kf[ks] = *(const bf16x8*)(kp + ks * 16); }
#pragma unroll 1
    for (int tile = tile_lo; tile < tile_hi; ++tile) {
        const int key = tile * 32 + r32; const int nxt = tile + 1 < tile_hi ? tile + 1 : tile; const bf16_t* kp = kbase + (size_t)(nxt * 32 + r32) * kstride + hh * 8;
        bf16x8 kn[4];
#pragma unroll
        for (int ks = 0; ks < 4; ++ks) kn[ks] = *(const bf16x8*)(kp + ks * 16);
        f32x16 S;
#pragma unroll
        for (int r = 0; r < 16; ++r) S[r] = 0.f;
#pragma unroll
        for (int ks = 0; ks < 4; ++ks) S = MFMA32(qa[ks], kf[ks], S);
#pragma unroll
        for (int g = 0; g < 4; ++g) { const bool ok = mask(g, key);
#pragma unroll
            for (int i = 0; i < 4; ++i) mc[4 * g + i] = ok ? fmaxf(mc[4 * g + i], S[4 * g + i]) : mc[4 * g + i]; }
#pragma unroll
        for (int ks = 0; ks < 4; ++ks) kf[ks] = kn[ks];
    }
#pragma unroll
    for (int r = 0; r < 16; ++r) mc[r] = half_max(mc[r]) * c1;
    { const bf16_t* kp = kbase + (size_t)(tile_lo * 32 + r32) * kstride + hh * 8;
#pragma unroll
      for (int ks = 0; ks < 4; ++ks) kf[ks] = *(const bf16x8*)(kp + ks * 16); }
#pragma unroll 1
    for (int tile = tile_lo; tile < tile_hi; ++tile) {
        const int key = tile * 32 + r32; const int nxt = tile + 1 < tile_hi ? tile + 1 : tile; const bf16_t* kp = kbase + (size_t)(nxt * 32 + r32) * kstride + hh * 8;
        bf16x8 kn[4], vf[4];
#pragma unroll
        for (int ks = 0; ks < 4; ++ks) kn[ks] = *(const bf16x8*)(kp + ks * 16);
#pragma unroll
        for (int q = 0; q < 4; ++q) vf[q] = *(const bf16x8*)(vT + (size_t)((q & 1) * 32 + r32) * vstride + tile * 32 + (q >> 1) * 16 + hh * 8);
        f32x16 S;
#pragma unroll
        for (int r = 0; r < 16; ++r) S[r] = 0.f;
#pragma unroll
        for (int ks = 0; ks < 4; ++ks) S = MFMA32(qa[ks], kf[ks], S);
#pragma unroll
        for (int g = 0; g < 4; ++g) { const bool ok = mask(g, key);
#pragma unroll
            for (int i = 0; i < 4; ++i) { const int r = 4 * g + i; const float pe = ok ? __builtin_amdgcn_exp2f(__builtin_fmaf(S[r], c1, -mc[r])) : 0.f; lr[r] += pe; Pst[crow(r, hh) * 40 + r32] = (bf16_t)pk2(pe, 0.f); } }
#pragma unroll
        for (int ks = 0; ks < 2; ++ks) { const bf16x8 a = *(const LAS bf16x8*)(Pst + r32 * 40 + ks * 16 + hh * 8);
#pragma unroll
            for (int n = 0; n < 2; ++n) O[n] = MFMA32(a, vf[ks * 2 + n], O[n]); }
#pragma unroll
        for (int ks = 0; ks < 4; ++ks) kf[ks] = kn[ks];
    }
#pragma unroll
    for (int r = 0; r < 16; ++r) lr[r] = half_sum(lr[r]);
}

struct WCmpMask { int tq[4]; DI bool operator()(int g, int key) const { return key <= 254 && 16 * key + 31 <= tq[g]; } };
struct WSelMask { int tq[4]; unsigned long long sel[4]; DI bool operator()(int g, int key) const { return key <= tq[g] && ((sel[g] >> (key >> 6)) & 1ull); } };
struct WWinMask { int tq[4]; DI bool operator()(int g, int key) const { return key <= tq[g] && tq[g] - key < 512; } };
DI void nsa_phase(unsigned char* ws, LAS unsigned char* lds, int c, int G) {
    const int tid = otid(), lane = tid & 63, wave = tid >> 6, r32 = lane & 31, hh = lane >> 5, pp = wave & 3, hf = wave >> 2, tl = r32 >> 2, hd = r32 & 3;
    const bf16_t* proj = (const bf16_t*)(ws + BIG_PROJ); bf16_t* ys = (bf16_t*)(ws + WS_YS);
    LAS unsigned char* wl = lds + wave * 19456;
    LAS float* pc = (LAS float*)(wl + 2560); LAS float* impv = (LAS float*)(wl + 10752); LAS float* xlm = (LAS float*)(wl + 11008); LAS float* outl = (LAS float*)(wl + 11520) + lane;
    LAS unsigned char* pl = lds + (wave ^ 4) * 19456; const LAS float* pxo = (const LAS float*)(pl + 2560); const LAS float* pxlm = (const LAS float*)(pl + 11008);
    LAS unsigned* selbuf = (LAS unsigned*)(lds + 8 * 19456 + 2048);
    const float c1 = 0.125f * 1.4426950408889634f;
    const int jm = hf == 0 ? pp : 7 - pp, jo = hf == 0 ? 7 - pp : pp;
    int bm, t0m, bo, t0o; bool valid; item_map(jm, c, G, bm, t0m, valid); item_map(jo, c, G, bo, t0o, valid);
    const bf16_t* projm = proj + (size_t)bm * SEQ * PN; const int ntm = t0m / 32 + 1; const bf16_t* qm = projm + (size_t)t0m * PN + C_NQ;
    const int tm = t0m + tl; const bf16_t* gp = projm + (size_t)tm * PN + C_NG + hd * 3;
    f32x16 O[2]; float lsum, mc;
    {
        bf16x8 qf[4];
#pragma unroll
        for (int ks = 0; ks < 4; ++ks) qf[ks] = *(const bf16x8*)(qm + (size_t)tl * PN + hd * 64 + ks * 16 + hh * 8);
        const bf16_t* kc = (const bf16_t*)(ws + S_KCMP) + (size_t)bm * 256 * 64; const bf16_t* vc = (const bf16_t*)(ws + S_VCMPT) + (size_t)bm * 64 * 256;
        int lim = tm >= 31 ? ((tm - 31) >> 4) : -1; lim = lim > 254 ? 254 : lim;
        TCmp cm{lim};
        wave_attn_t(qf, kc, vc, 0, 8, c1, cm, lane, hh, O, lsum, mc);
        const float invc = 1.0f / fmaxf(lsum, 1e-30f);
        { const float gt = sigmoidf_(bf2f(gp[0])) * invc;
#pragma unroll
          for (int r = 0; r < 16; ++r) { outl[r * 64] = gt * O[0][r]; outl[(16 + r) * 64] = gt * O[1][r]; } }
#pragma unroll 1
        for (int tile = 0; tile < 8; ++tile) {
            const bf16_t* kp = kc + ((size_t)tile * 256 + lane) * 8;
            f32x16 S;
#pragma unroll
            for (int r = 0; r < 16; ++r) S[r] = 0.f;
#pragma unroll
            for (int ks = 0; ks < 4; ++ks) S = MFMA32(*(const bf16x8*)(kp + ks * 512), qf[ks], S);
            const unsigned al = cm(tile) >> (4 * hh);
#pragma unroll
            for (int r = 0; r < 16; ++r) { float v = ((al >> CBIT(r)) & 1u) ? __builtin_amdgcn_exp2f(__builtin_fmaf(S[r], c1, -mc)) * invc : 0.f;
                v += __shfl_xor(v, 1); v += __shfl_xor(v, 2);
                if (hd == 0) pc[tl * 256 + tile * 32 + crow(r, hh)] = v; }
        }
#pragma unroll 1
        for (int q8 = 0; q8 < 8; ++q8) {
            const int jb = lane, t = t0m + q8, cur = t >> 6; float imp = 0.f;
#pragma unroll
            for (int k = -1; k < 4; ++k) { const int ci = 4 * jb + k; if (ci >= 0 && ci < 255) { const float pv = pc[q8 * 256 + ci]; imp += (k == -1 || k == 3) ? 0.5f * pv : pv; } }
            const bool forced = jb == 0 || jb == cur || jb == cur - 1, adm = jb <= cur;
            const float val = adm ? (forced ? __builtin_inff() : imp) : -__builtin_inff();
            impv[jb] = val;
            int rank = 0;
            for (int q = 0; q < 64; ++q) { const float o = impv[q]; rank += (o > val || (o == val && q < jb)) ? 1 : 0; }
            const unsigned long long bal = __ballot(rank < 16);
            if (lane == 0) { selbuf[(jm * 8 + q8) * 2] = (unsigned)bal; selbuf[(jm * 8 + q8) * 2 + 1] = (unsigned)(bal >> 32); }
        }
        TWin wm{tm};
        const int tlo = (t0m > 511 ? t0m - 511 : 0) >> 5;
        wave_attn_t(qf, (const bf16_t*)(ws + KF_NKW) + (size_t)bm * SEQ * 64, (const bf16_t*)(ws + X_NVWT) + (size_t)bm * 64 * SEQ, tlo, ntm, c1, wm, lane, hh, O, lsum, mc);
        { const float gt = sigmoidf_(bf2f(gp[2])) / fmaxf(lsum, 1e-30f);
#pragma unroll
          for (int r = 0; r < 16; ++r) { outl[r * 64] += gt * O[0][r]; outl[(16 + r) * 64] += gt * O[1][r]; } }
    }
    __syncthreads();
#pragma unroll 1
    for (int pass = 0; pass < 2; ++pass) {
        const int jj = pass == 0 ? jo : jm, bb = pass == 0 ? bo : bm, t0 = pass == 0 ? t0o : t0m;
        const bf16_t* projb = proj + (size_t)bb * SEQ * PN; const int nt = t0 / 32 + 1, mid = nt >> 1; const bf16_t* qb = projb + (size_t)t0 * PN + C_NQ;
        bf16x8 qf[4];
#pragma unroll
        for (int ks = 0; ks < 4; ++ks) qf[ks] = *(const bf16x8*)(qb + (size_t)tl * PN + hd * 64 + ks * 16 + hh * 8);
        TSel sm{t0 + tl, (unsigned long long)selbuf[(jj * 8 + tl) * 2] | ((unsigned long long)selbuf[(jj * 8 + tl) * 2 + 1] << 32)};
        wave_attn_t(qf, (const bf16_t*)(ws + KF_NKS) + (size_t)bb * SEQ * 64, (const bf16_t*)(ws + X_NVST) + (size_t)bb * 64 * SEQ, hf ? mid : 0, hf ? nt : mid, c1, sm, lane, hh, O, lsum, mc);
        if (pass == 0) put_partial_t(O, lsum, mc, pc, xlm, lane);
    }
    __syncthreads();
    lse_merge_t(O, lsum, mc, pxo, pxlm, lane);
    { const float gt = sigmoidf_(bf2f(gp[1]));
#pragma unroll
      for (int r = 0; r < 16; ++r) { O[0][r] = outl[r * 64] + gt * O[0][r]; O[1][r] = outl[(16 + r) * 64] + gt * O[1][r]; } }
    store_rows_t(O, ys + (size_t)(bm * SEQ + tm) * DM + 512 + hd * 64, hh);
    __syncthreads();
}

struct MergeOrder {
    int G, c; long a_ys, b_wb;
    DI bool next(int i, pg8::Unit& u) const {
        const int tile = c + (i >> 3) * G; if (tile >= 256) return false;
        const int sub = i & 7, b = sub >> 1, kind = sub & 1; u.pm = tile >> 2; u.pn = tile & 3; u.aux = sub;
        if (kind == 0) { u.aoff = 0; u.boff = (long)b * 1024 * 1024 * 2; u.nt = 16; } else { u.aoff = a_ys + b * 512; u.boff = b_wb + b * 512; u.nt = 4; }
        return true;
    }
};
struct EpiMerge {
    static constexpr bool PERM = true;
    bf16_t* gbuf; bf16_t* merged;
    DI void operator()(const f32x4 (&acc)[2][2][4][2], const pg8::Unit& u, int wr, int wc, int fr, int fq) const {
        const int row0 = u.pm * 256 + wr * 64 + fr, col0 = u.pn * 256 + wc * 32 + 8 * fq; const int kind = u.aux & 1, b = u.aux >> 1;
#pragma unroll
        for (int ai = 0; ai < 2; ++ai)
#pragma unroll
            for (int m = 0; m < 4; ++m) { const size_t ro = (size_t)(row0 + ai * 128 + m * 16) * DM + col0;
#pragma unroll
                for (int bj = 0; bj < 2; ++bj) { const f32x4 v0 = acc[ai][bj][m][0], v1 = acc[ai][bj][m][1]; const size_t off = ro + bj * 128;
                    if (kind == 0) { u32x4 w; w.x = pk2(sigmoidf_(v0[0]), sigmoidf_(v0[1])); w.y = pk2(sigmoidf_(v0[2]), sigmoidf_(v0[3])); w.z = pk2(sigmoidf_(v1[0]), sigmoidf_(v1[1])); w.w = pk2(sigmoidf_(v1[2]), sigmoidf_(v1[3]));
                        *(u32x4*)(gbuf + off) = w; }
                    else { const u32x4 gq = *(const u32x4*)(gbuf + off); u32x4 pq = {0u, 0u, 0u, 0u}; if (b > 0) pq = *(const u32x4*)(merged + off);
                        float r[8];
                        r[0] = __uint_as_float(gq.x << 16) * v0[0] + __uint_as_float(pq.x << 16); r[1] = __uint_as_float(gq.x & 0xffff0000u) * v0[1] + __uint_as_float(pq.x & 0xffff0000u);
                        r[2] = __uint_as_float(gq.y << 16) * v0[2] + __uint_as_float(pq.y << 16); r[3] = __uint_as_float(gq.y & 0xffff0000u) * v0[3] + __uint_as_float(pq.y & 0xffff0000u);
                        r[4] = __uint_as_float(gq.z << 16) * v1[0] + __uint_as_float(pq.z << 16); r[5] = __uint_as_float(gq.z & 0xffff0000u) * v1[1] + __uint_as_float(pq.z & 0xffff0000u);
                        r[6] = __uint_as_float(gq.w << 16) * v1[2] + __uint_as_float(pq.w << 16); r[7] = __uint_as_float(gq.w & 0xffff0000u) * v1[3] + __uint_as_float(pq.w & 0xffff0000u);
                        u32x4 w; w.x = pk2(r[0], r[1]); w.y = pk2(r[2], r[3]); w.z = pk2(r[4], r[5]); w.w = pk2(r[6], r[7]);
                        *(u32x4*)(merged + off) = w; } } }
    }
};


DI void cvt_wmix(const Params& p, int l, LAS unsigned char* lds, int c, int G) {
    unsigned char* ws = p.ws;
    cvt_matrix(p.in[IN_WIN] + (size_t)l * DM * DIN, DM, DIN, (bf16_t*)(ws + W_IN), PN, MAP_IN, lds, c, G);
    cvt_matrix(p.in[IN_WIN] + (size_t)l * DM * DIN, DM, DIN, (bf16_t*)(ws + W_G), 4096, MAP_GATE, lds, c, G);
    cvt_matrix(p.in[IN_WBR] + (size_t)l * DM * DM, DM, DM, (bf16_t*)(ws + W_B), DM, MAP_ID, lds, c, G);
    cvt_matrix(p.in[IN_WOUT] + (size_t)l * DM * DM, DM, DM, (bf16_t*)(ws + W_OUT), DM, MAP_ID, lds, c, G);
    cvt_matrix(p.in[IN_XQ] + (size_t)l * DM * DM, DM, DM, (bf16_t*)(ws + W_Q), DM, MAP_ID, lds, c, G);
    cvt_matrix(p.in[IN_XKV] + (size_t)l * DM * 2 * DM, DM, 2 * DM, (bf16_t*)(ws + W_KV), 2 * DM, MAP_ID, lds, c, G);
    cvt_matrix(p.in[IN_XO] + (size_t)l * DM * DM, DM, DM, (bf16_t*)(ws + W_O), DM, MAP_ID, lds, c, G);
    for (int i = 0; i < 2; ++i) {
        cvt_matrix(p.in[IN_C1] + (size_t)(l * 2 + i) * 2048 * 64, 2048, 64, (bf16_t*)(ws + W_C1) + (size_t)i * 64 * 2048, 64, MAP_ID, lds, c, G);
        cvt_matrix(p.in[IN_C2] + (size_t)(l * 2 + i) * 64 * 64, 64, 64, (bf16_t*)(ws + W_C2) + (size_t)i * 64 * 64, 64, MAP_ID, lds, c, G);
    }
}

template <int l> DI void layer_body(const Params& p, const XcdBarrier& xbar, LAS unsigned char* lds, int c, int G) {
    unsigned char* ws = p.ws;
    float* xf = (float*)(ws + WS_XF); bf16_t* xb = (bf16_t*)(ws + WS_XB);

        const float* lng = p.in[IN_LNG] + (size_t)l * 4 * DM; const float* lnb = p.in[IN_LNB] + (size_t)l * 4 * DM;
        { pg8::TileOrder S; S.init(NTOK, 2 * DFF, DM, G, c); pg8::Gemm g{xb, (const bf16_t*)(ws + W_GU), DM, DM}; pg8::EpiSwiGLU E{(bf16_t*)(ws + BIG_H)}; pg8::gemm_phase(lds, g, S, E); }
        xcd_barrier(xbar);
        { pg8::TileOrder S; S.init(NTOK, DM, DFF, G, c); pg8::Gemm g{(const bf16_t*)(ws + BIG_H), (const bf16_t*)(ws + W_DOWN), DFF, DFF}; pg8::EpiResid E{xf, 0.5f}; pg8::gemm_phase(lds, g, S, E); }
        xcd_barrier(xbar);
        ln_phase(xf, xb, nullptr, lng, lnb, c, G);
        xcd_barrier(xbar);
        { pg8::TileOrder S; S.init(NTOK, PN, DM, G, c); pg8::Gemm g{xb, (const bf16_t*)(ws + W_IN), DM, DM}; pg8::EpiBf16 E{(bf16_t*)(ws + BIG_PROJ), PN}; pg8::gemm_phase(lds, g, S, E); }
        xcd_barrier(xbar);
        prep_phase(ws, lds, c, G);
        xcd_barrier(xbar);
        compress_phase(p, l, ws, lds, c, G);
        ret_state_phase(ws, c, G);
        ssd_state_phase(p, l, ws, lds, c, G);
        xcd_barrier(xbar);
        ret_scan_phase(ws, c, G);
        ssd_scan_phase(ws, c, G);
        xcd_barrier(xbar);
        ret_out_phase(ws, lds, c, G);
        ssd_out_phase(p, l, ws, lds, c, G);
        dsa_phase(ws, lds, c, G);
        nsa_phase(ws, lds, c, G);
        xcd_barrier(xbar);
        { MergeOrder S{G, c, (long)WS_YS - (long)WS_XB, (long)W_B - (long)W_G}; pg8::Gemm g{xb, (const bf16_t*)(ws + W_G), DM, DM}; EpiMerge E{(bf16_t*)(ws + BIG_GBUF), (bf16_t*)(ws + BIG_MERGED)}; pg8::gemm_phase(lds, g, S, E); }
        xcd_barrier(xbar);
        { pg8::TileOrder S; S.init(NTOK, DM, DM, G, c); pg8::Gemm g{(const bf16_t*)(ws + BIG_MERGED), (const bf16_t*)(ws + W_OUT), DM, DM}; pg8::EpiResid E{xf, 1.0f}; pg8::gemm_phase(lds, g, S, E); }
        xcd_barrier(xbar);
        ln_phase(xf, xb, nullptr, lng + DM, lnb + DM, c, G);
        cvt_matrix(p.in[IN_F2GU] + (size_t)l * DM * 2 * DFF, DM, 2 * DFF, (bf16_t*)(ws + W_GU), 2 * DFF, MAP_GU, lds, c, G);
        cvt_matrix(p.in[IN_F2DN] + (size_t)l * DFF * DM, DFF, DM, (bf16_t*)(ws + W_DOWN), DM, MAP_ID, lds, c, G);
        xcd_barrier(xbar);
        { pg8::TileOrder S; S.init(NTOK, DM, DM, G, c); pg8::Gemm g{xb, (const bf16_t*)(ws + W_Q), DM, DM}; pg8::EpiBf16 E{(bf16_t*)(ws + BIG_QX), DM}; pg8::gemm_phase(lds, g, S, E); }
        { pg8::TileOrder S; S.init(NB * NMEM, 2 * DM, DM, G, c); pg8::Gemm g{(const bf16_t*)(ws + S_MEMB), (const bf16_t*)(ws + W_KV), DM, DM}; EpiKV E{(bf16_t*)(ws + S_KVX), (bf16_t*)(ws + S_KVX + 2 * MiB)}; pg8::gemm_phase(lds, g, S, E); }
        xcd_barrier(xbar);
        xattn_phase((const bf16_t*)(ws + BIG_QX), (const bf16_t*)(ws + S_KVX), (const bf16_t*)(ws + S_KVX + 2 * MiB), (bf16_t*)(ws + BIG_AO), lds, c, G);
        xcd_barrier(xbar);
        { pg8::TileOrder S; S.init(NTOK, DM, DM, G, c); pg8::Gemm g{(const bf16_t*)(ws + BIG_AO), (const bf16_t*)(ws + W_O), DM, DM}; pg8::EpiResid E{xf, 1.0f}; pg8::gemm_phase(lds, g, S, E); }
        xcd_barrier(xbar);
        ln_phase(xf, xb, nullptr, lng + 2 * DM, lnb + 2 * DM, c, G);
        xcd_barrier(xbar);
        { pg8::TileOrder S; S.init(NTOK, 2 * DFF, DM, G, c); pg8::Gemm g{xb, (const bf16_t*)(ws + W_GU), DM, DM}; pg8::EpiSwiGLU E{(bf16_t*)(ws + BIG_H)}; pg8::gemm_phase(lds, g, S, E); }
        xcd_barrier(xbar);
        { pg8::TileOrder S; S.init(NTOK, DM, DFF, G, c); pg8::Gemm g{(const bf16_t*)(ws + BIG_H), (const bf16_t*)(ws + W_DOWN), DFF, DFF}; pg8::EpiResid E{xf, 0.5f}; pg8::gemm_phase(lds, g, S, E); }
        xcd_barrier(xbar);
        ln_phase(xf, xb, l == DEPTH - 1 ? p.out : nullptr, lng + 3 * DM, lnb + 3 * DM, c, G);
        if (l + 1 < DEPTH) {
            cvt_matrix(p.in[IN_F1GU] + (size_t)(l + 1) * DM * 2 * DFF, DM, 2 * DFF, (bf16_t*)(ws + W_GU), 2 * DFF, MAP_GU, lds, c, G);
            cvt_matrix(p.in[IN_F1DN] + (size_t)(l + 1) * DFF * DM, DFF, DM, (bf16_t*)(ws + W_DOWN), DM, MAP_ID, lds, c, G);
            cvt_wmix(p, l + 1, lds, c, G);
        }
        xcd_barrier(xbar);
}

__global__ void __launch_bounds__(NTHREADS) mega(Params p) {
    extern __shared__ __attribute__((aligned(16))) unsigned char lds_raw[];
    LAS unsigned char* lds = (LAS unsigned char*)lds_raw;
    cg::grid_group grid = cg::this_grid();
    const int G = gridDim.x, c = blockIdx.x;
    if (threadIdx.x == 0) { LAS unsigned* z = (LAS unsigned*)(lds + L_XBST); z[0] = 0u; z[1] = 0u; z[2] = 0u; z[3] = 0u; }
    __syncthreads();
    const XcdBarrier xbar = xcd_barrier_post((unsigned*)(p.ws + S_BAR), (volatile LAS unsigned*)(lds + L_XBST));
    unsigned char* ws = p.ws;
    float* xf = (float*)(ws + WS_XF); bf16_t* xb = (bf16_t*)(ws + WS_XB);

    {
        const f32x4* xi = (const f32x4*)p.in[IN_X]; const int tid = otid();
        for (size_t i = (size_t)c * NTHREADS + tid; i < (size_t)NTOK * DM / 4; i += (size_t)G * NTHREADS) { const f32x4 v = xi[i]; ((f32x4*)xf)[i] = v; u32x2 w; w.x = pk2(v[0], v[1]); w.y = pk2(v[2], v[3]); ((u32x2*)xb)[i] = w; }
        cvt_matrix(p.in[IN_F1GU], DM, 2 * DFF, (bf16_t*)(ws + W_GU), 2 * DFF, MAP_GU, lds, c, G);
        cvt_matrix(p.in[IN_F1DN], DFF, DM, (bf16_t*)(ws + W_DOWN), DM, MAP_ID, lds, c, G);
        cvt_wmix(p, 0, lds, c, G);
        table_phase(ws, c, G);
        const f32x4* mi = (const f32x4*)p.in[IN_MEM]; bf16_t* memb = (bf16_t*)(ws + S_MEMB);
        for (size_t i = (size_t)c * NTHREADS + tid; i < (size_t)NB * NMEM * DM / 4; i += (size_t)G * NTHREADS) { const f32x4 v = mi[i]; u32x2 w; w.x = pk2(v[0], v[1]); w.y = pk2(v[2], v[3]); ((u32x2*)memb)[i] = w; }
    }
    grid.sync();
    layer_body<0>(p, xbar, lds, c, G);
    layer_body<1>(p, xbar, lds, c, G);
}

extern "C" void kernel_launch(void* const* d_in, const int* in_sizes, int n_in, void* d_out, int out_size, void* d_ws, size_t ws_size, hipStream_t stream) {
    static int grid = 0;
    if (grid == 0) {
        if (n_in != 23 || out_size != NTOK * DM || ws_size < WS_END) { fprintf(stderr, "kernel_launch: unexpected shapes (n_in %d out %d ws %zu need %zu)\n", n_in, out_size, ws_size, (size_t)WS_END); grid = -1; return; }
        int dev = 0, cus = 0, per_cu = 0;
        hipGetDevice(&dev); hipDeviceGetAttribute(&cus, hipDeviceAttributeMultiprocessorCount, dev);
        if (hipFuncSetAttribute((const void*)mega, hipFuncAttributeMaxDynamicSharedMemorySize, LDS_BYTES) != hipSuccess) { fprintf(stderr, "kernel_launch: hipFuncSetAttribute failed\n"); grid = -1; return; }
        if (hipOccupancyMaxActiveBlocksPerMultiprocessor(&per_cu, (const void*)mega, NTHREADS, LDS_BYTES) != hipSuccess || per_cu < 1) { fprintf(stderr, "kernel_launch: occupancy query says %d\n", per_cu); grid = -1; return; }
        if (cus != 256) { fprintf(stderr, "kernel_launch: built for a 256-CU device (got %d)\n", cus); grid = -1; return; }
        grid = cus;
    }
    if (grid < 0) return;
    if (hipMemsetAsync((char*)d_ws + S_BAR, 0, XCD_BAR_WORDS * 4, stream) != hipSuccess) { fprintf(stderr, "kernel_launch: memset failed\n"); return; }
    Params p{};
    for (int i = 0; i < 23; ++i) p.in[i] = (const float*)d_in[i];
    p.out = (float*)d_out; p.ws = (unsigned char*)d_ws; p.phase_lo = 0; p.phase_hi = 1000;
    void* args[] = {&p};
    hipError_t e = hipLaunchCooperativeKernel((const void*)mega, dim3(grid), dim3(NTHREADS), args, LDS_BYTES, stream);
    if (e != hipSuccess) fprintf(stderr, "cooperative launch failed: %s (grid %d)\n", hipGetErrorString(e), grid);
}
```
